# Optimizing an MI355X kernel written in HIP

```python
import math
import jax, jax.numpy as jnp
from jax import lax
import numpy as np

D_MODEL = 2048
BATCH = 4
SEQ = 2048
DEPTH = 2

GRID_W = 64
CTX_LEN = 256
D_MIX = D_MODEL
FOURIER_W = D_MODEL // 4
FOURIER_GROUPS = 4
FOURIER_GW = FOURIER_W // FOURIER_GROUPS
CONV_W = D_MODEL // 4
CONV_K = 31
ATT_W = D_MODEL // 2
DIFF_HEAD_DIM = 64
DIFF_HEADS = ATT_W // (2 * DIFF_HEAD_DIM)
D_FF = 4 * D_MODEL
Q_BLOCK = 128
ROPE_BASE = 10000.0
EPS = 1e-6

OFF_CONV = FOURIER_W
OFF_Q = OFF_CONV + 2 * CONV_W
OFF_K = OFF_Q + ATT_W
OFF_V = OFF_K + ATT_W
IN_COLS = OFF_V + ATT_W

kernel_name = "hybrid_fourier_conformer_diffattn_dit_block"


def rms_norm(x, g):
    xf = x.astype(jnp.float32)
    y = xf * lax.rsqrt(jnp.mean(xf * xf, axis=-1, keepdims=True) + EPS)
    return (y * g.astype(jnp.float32)).astype(x.dtype)


def layer_norm(x, g, b):
    xf = x.astype(jnp.float32)
    mu = jnp.mean(xf, axis=-1, keepdims=True)
    xc = xf - mu
    y = xc * lax.rsqrt(jnp.mean(xc * xc, axis=-1, keepdims=True) + EPS)
    return (y * g.astype(jnp.float32) + b.astype(jnp.float32)).astype(x.dtype)


def modulate(h, shift, scale):
    return h * (1 + scale) + shift


def axial_rope(n):
    rows = n // GRID_W
    row = jnp.repeat(jnp.arange(rows), GRID_W).astype(jnp.float32)
    col = jnp.tile(jnp.arange(GRID_W), rows).astype(jnp.float32)
    n_freq = DIFF_HEAD_DIM // 4
    inv = ROPE_BASE ** (-jnp.arange(n_freq, dtype=jnp.float32) / n_freq)
    ang = jnp.concatenate([row[:, None] * inv, col[:, None] * inv], axis=-1)
    return jnp.cos(ang), jnp.sin(ang)


def apply_rope(t, cos, sin):
    half = DIFF_HEAD_DIM // 2
    tf = t.astype(jnp.float32)
    cs = cos[None, :, None, None, :]
    sn = sin[None, :, None, None, :]
    t1, t2 = tf[..., :half], tf[..., half:]
    out = jnp.concatenate([t1 * cs - t2 * sn, t2 * cs + t1 * sn], axis=-1)
    return out.astype(t.dtype)


def fourier_mixer(u, w_f):
    b, L, _ = u.shape
    ug = u.reshape(b, L, FOURIER_GROUPS, FOURIER_GW).astype(jnp.float32)
    z = jnp.fft.fft2(ug, axes=(1, 3), norm="ortho").real.astype(u.dtype)
    return jnp.einsum('blgc,gce->blge', z, w_f).reshape(b, L, FOURIER_W)


def conv_module(u, w_dw, b_dw, g_ln, b_ln, w_pw, b_pw):
    a, gt = jnp.split(u, 2, axis=-1)
    z = a * jax.nn.sigmoid(gt)
    z = lax.conv_general_dilated(
        z, w_dw[:, None, :], window_strides=(1,),
        padding=[(CONV_K // 2, CONV_K // 2)],
        dimension_numbers=('NWC', 'WIO', 'NWC'),
        feature_group_count=CONV_W) + b_dw
    z = jax.nn.silu(layer_norm(z, g_ln, b_ln))
    return z @ w_pw + b_pw


def diff_attend(q, k, v, lam):
    s = jnp.einsum('bqhmd,bkhmd->bhmqk', q, k).astype(jnp.float32) * (DIFF_HEAD_DIM ** -0.5)
    p = jax.nn.softmax(s, axis=-1)
    a = p[:, :, 0] - lam * p[:, :, 1]
    return jnp.einsum('bhqk,bkhe->bqhe', a.astype(v.dtype), v)


def split_heads_qk(t):
    b, L, _ = t.shape
    return t.reshape(b, L, DIFF_HEADS, 2, DIFF_HEAD_DIM)


def split_heads_v(t):
    b, L, _ = t.shape
    return t.reshape(b, L, DIFF_HEADS, 2 * DIFF_HEAD_DIM)


def setup_inputs(seed: int = 0) -> dict:
    key = jax.random.key(seed)
    ks = jax.random.split(key, 32)
    f32 = jnp.float32
    nrm = lambda k, shape, s: jax.random.normal(k, shape, f32) * s
    gain = lambda k, shape: 1.0 + 0.05 * jax.random.normal(k, shape, f32)
    L = DEPTH
    return {
        "x": nrm(ks[0], (BATCH, SEQ, D_MODEL), 1.0),
        "c": nrm(ks[1], (BATCH, D_MODEL), 1.0),
        "ctx": nrm(ks[2], (BATCH, CTX_LEN, D_MODEL), 1.0),
        "c_ctx": nrm(ks[3], (D_MODEL,), 1.0),
        "w_ada": nrm(ks[4], (L, D_MODEL, 6 * D_MODEL), 0.5 * D_MODEL ** -0.5),
        "b_ada": nrm(ks[5], (L, 6 * D_MODEL), 0.02),
        "g_pre_mix": gain(ks[6], (L, D_MODEL)),
        "g_post_mix": gain(ks[7], (L, D_MODEL)),
        "g_pre_mlp": gain(ks[8], (L, D_MODEL)),
        "g_post_mlp": gain(ks[9], (L, D_MODEL)),
        "w_in": nrm(ks[10], (L, D_MODEL, IN_COLS), D_MODEL ** -0.5),
        "w_out": nrm(ks[11], (L, D_MIX, D_MODEL), D_MIX ** -0.5),
        "w_fourier": nrm(ks[12], (L, FOURIER_GROUPS, FOURIER_GW, FOURIER_GW), FOURIER_GW ** -0.5),
        "w_dw": nrm(ks[13], (L, CONV_K, CONV_W), CONV_K ** -0.5),
        "b_dw": nrm(ks[14], (L, CONV_W), 0.02),
        "g_conv_ln": gain(ks[15], (L, CONV_W)),
        "b_conv_ln": nrm(ks[16], (L, CONV_W), 0.02),
        "w_conv_pw": nrm(ks[17], (L, CONV_W, CONV_W), CONV_W ** -0.5),
        "b_conv_pw": nrm(ks[18], (L, CONV_W), 0.02),
        "lambda_q1": nrm(ks[19], (L, DIFF_HEAD_DIM), 0.1),
        "lambda_k1": nrm(ks[20], (L, DIFF_HEAD_DIM), 0.1),
        "lambda_q2": nrm(ks[21], (L, DIFF_HEAD_DIM), 0.1),
        "lambda_k2": nrm(ks[22], (L, DIFF_HEAD_DIM), 0.1),
        "g_subln": gain(ks[23], (L, 2 * DIFF_HEAD_DIM)),
        "w_mlp_in": nrm(ks[24], (L, D_MODEL, D_FF), D_MODEL ** -0.5),
        "w_mlp_out": nrm(ks[25], (L, D_FF, D_MODEL), D_FF ** -0.5),
    }


def reference(x, c, ctx, c_ctx, w_ada, b_ada, g_pre_mix, g_post_mix, g_pre_mlp, g_post_mlp,
              w_in, w_out, w_fourier, w_dw, b_dw, g_conv_ln, b_conv_ln, w_conv_pw, b_conv_pw,
              lambda_q1, lambda_k1, lambda_q2, lambda_k2, g_subln, w_mlp_in, w_mlp_out):
    bsz, n, _ = x.shape
    n_blocks = n // Q_BLOCK
    cos, sin = axial_rope(n)
    cx = ctx
    for l in range(DEPTH):
        last = l == DEPTH - 1
        mod_lat = (jax.nn.silu(c) @ w_ada[l] + b_ada[l])[:, None, :]
        mod_ctx = jax.nn.silu(c_ctx) @ w_ada[l] + b_ada[l]
        sh1, sc1, g1, sh2, sc2, g2 = jnp.split(mod_lat, 6, axis=-1)
        csh1, csc1, cg1, csh2, csc2, cg2 = jnp.split(mod_ctx, 6, axis=-1)

        lam_init = 0.8 - 0.6 * math.exp(-0.3 * l)
        lq1 = lambda_q1[l].astype(jnp.float32); lk1 = lambda_k1[l].astype(jnp.float32)
        lq2 = lambda_q2[l].astype(jnp.float32); lk2 = lambda_k2[l].astype(jnp.float32)
        lam = jnp.exp(jnp.sum(lq1 * lk1)) - jnp.exp(jnp.sum(lq2 * lk2)) + lam_init

        def attn_post(o):
            o = rms_norm(o, g_subln[l]) * (1 - lam_init)
            return o.reshape(o.shape[0], o.shape[1], ATT_W)

        def mixer_concat(f_in, cv_in, attn_out):
            yf = fourier_mixer(f_in, w_fourier[l])
            yc = conv_module(cv_in, w_dw[l], b_dw[l], g_conv_ln[l], b_conv_ln[l],
                             w_conv_pw[l], b_conv_pw[l])
            return jnp.concatenate([yf, yc, attn_out], axis=-1) @ w_out[l]

        h = modulate(rms_norm(x, g_pre_mix[l]), sh1, sc1)
        hc = modulate(rms_norm(cx, g_pre_mix[l]), csh1, csc1)
        p = h @ w_in[l]
        f_in, cv_in, q, k, v = jnp.split(p, [OFF_CONV, OFF_Q, OFF_K, OFF_V], axis=-1)
        pc_kv = hc @ w_in[l][:, OFF_K:]
        kc, vc = jnp.split(pc_kv, 2, axis=-1)

        q_h = apply_rope(split_heads_qk(q), cos, sin)
        k_h = apply_rope(split_heads_qk(k), cos, sin)
        kc_h = split_heads_qk(kc)
        k_all = jnp.concatenate([kc_h, k_h], axis=1)
        v_all = jnp.concatenate([split_heads_v(vc), split_heads_v(v)], axis=1)

        qb = jnp.moveaxis(q_h.reshape(bsz, n_blocks, Q_BLOCK, DIFF_HEADS, 2, DIFF_HEAD_DIM), 1, 0)
        ob = lax.map(lambda qq: diff_attend(qq, k_all, v_all, lam), qb)
        o = jnp.moveaxis(ob, 0, 1).reshape(bsz, n, DIFF_HEADS, 2 * DIFF_HEAD_DIM)
        y = mixer_concat(f_in, cv_in, attn_post(o))

        if not last:
            pc_rest = hc @ w_in[l][:, :OFF_K]
            fc_in, cvc_in, qc = jnp.split(pc_rest, [OFF_CONV, OFF_Q], axis=-1)
            oc = diff_attend(split_heads_qk(qc), kc_h, split_heads_v(vc), lam)
            yc = mixer_concat(fc_in, cvc_in, attn_post(oc))
            cx = cx + cg1 * rms_norm(yc, g_post_mix[l])
            hc2 = modulate(rms_norm(cx, g_pre_mlp[l]), csh2, csc2)
            yc2 = jnp.square(jax.nn.relu(hc2 @ w_mlp_in[l])) @ w_mlp_out[l]
            cx = cx + cg2 * rms_norm(yc2, g_post_mlp[l])

        x = x + g1 * rms_norm(y, g_post_mix[l])

        h2 = modulate(rms_norm(x, g_pre_mlp[l]), sh2, sc2)
        y2 = jnp.square(jax.nn.relu(h2 @ w_mlp_in[l])) @ w_mlp_out[l]
        x = x + g2 * rms_norm(y2, g_post_mlp[l])
    return x
```

```cpp
#include <hip/hip_runtime.h>
#include <hip/hip_cooperative_groups.h>
#include <cstdio>
namespace cg = cooperative_groups;

#ifndef MK_MULTI
#define MK_MULTI 0
#endif

#ifndef PROBE_DUP
#define PROBE_DUP 0
#endif
#define LAS __attribute__((address_space(3)))
typedef unsigned short bf16_t;
typedef short bf16x8 __attribute__((ext_vector_type(8)));
typedef float f32x4 __attribute__((ext_vector_type(4)));
typedef float f32x16 __attribute__((ext_vector_type(16)));
typedef unsigned u32x4 __attribute__((ext_vector_type(4)));
typedef unsigned u32x2 __attribute__((ext_vector_type(2)));

constexpr int D = 2048, NB = 4, SEQ = 2048, CTXL = 256, NLAT = NB * SEQ, NCTX = NB * CTXL, NROW = NLAT + NCTX;
constexpr int DFF = 8192, LK = CTXL + SEQ, INC = 4608, NH = 8;
constexpr float EPS = 1e-6f;
constexpr float QSCALE = 0.125f * 1.4426950408889634f;
constexpr int NTHR = 512;
constexpr int LDS_BYTES = 131072;
constexpr int LDS_TOTAL = LDS_BYTES + 64;

constexpr size_t al256(size_t x) { return (x + 255) & ~(size_t)255; }
constexpr size_t SZ_WINT = (size_t)5120 * 2048 * 2, SZ_WINF = (size_t)2048 * 640 * 2, SZ_MTP = (size_t)1024 * 256 * 2, SZ_WOUTF = (size_t)2048 * 2048 * 2,
                 SZ_WTMP = (size_t)2048 * 512 * 2, SZ_WPW = (size_t)512 * 512 * 2, SZ_WMI = (size_t)8192 * 2048 * 2, SZ_WMO = SZ_WMI;
constexpr size_t O_WINT = 0;
constexpr size_t O_WINF = O_WINT + 2 * SZ_WINT;
constexpr size_t O_MTP = O_WINF + 2 * SZ_WINF;
constexpr size_t O_WOUTF = O_MTP + 2 * SZ_MTP;
constexpr size_t O_WTMP = O_WOUTF + 2 * SZ_WOUTF;
constexpr size_t O_WPW = O_WTMP + 2 * SZ_WTMP;
constexpr size_t O_WMI = O_WPW + 2 * SZ_WPW;
constexpr size_t O_WMO = O_WMI + 2 * SZ_WMI;
constexpr size_t O_DFT = O_WMO + 2 * SZ_WMO;
constexpr size_t O_DFTC = O_DFT + (size_t)2048 * 4096 * 2;
constexpr size_t O_MOD = O_DFTC + (size_t)256 * 512 * 2;
constexpr size_t O_BO = O_MOD + al256((size_t)2 * 5 * 12288 * 4);
constexpr size_t O_ROPE = O_BO + (size_t)2 * 2048 * 4;
constexpr size_t O_MISC = O_ROPE + (size_t)2048 * 64 * 4;
constexpr size_t O_KMAX = O_MISC + 1024;
constexpr size_t O_CX = O_MISC + 2048;
constexpr size_t O_H = O_CX + (size_t)NCTX * D * 4;
constexpr size_t O_ABT = O_H + (size_t)NROW * D * 2;
constexpr size_t O_ABTC = O_ABT + (size_t)512 * 16384 * 2;
constexpr size_t O_Z = O_ABTC + (size_t)512 * 2048 * 2;
constexpr size_t O_Q = O_Z + (size_t)NROW * 512 * 2;
constexpr size_t O_KK = O_Q + (size_t)NROW * 1024 * 2;
constexpr size_t O_VT = O_KK + (size_t)NB * NH * 2 * LK * 64 * 2;
constexpr size_t O_CAT = O_VT + (size_t)NB * NH * 128 * LK * 2;
constexpr size_t O_Y = O_CAT + (size_t)NROW * D * 2;
constexpr size_t O_YP = O_Y + (size_t)NROW * D * 4;
constexpr size_t O_T = O_YP + (size_t)8 * NCTX * D * 4;
constexpr size_t O_BAR = O_T + (size_t)NROW * DFF * 2;
constexpr size_t O_X16 = O_BAR + 16384;
constexpr size_t WS_END = O_X16 + (size_t)NROW * D * 2;

struct Params {
    const float *x, *c, *ctx, *c_ctx, *w_ada, *b_ada, *g_pre_mix, *g_post_mix, *g_pre_mlp, *g_post_mlp, *w_in, *w_out, *w_fourier, *w_dw, *b_dw,
        *g_conv_ln, *b_conv_ln, *w_conv_pw, *b_conv_pw, *lq1, *lk1, *lq2, *lk2, *g_subln, *w_mlp_in, *w_mlp_out;
    float* out; unsigned char* ws; int ph_lo, ph_hi;
};

__device__ __forceinline__ unsigned pk2(float lo, float hi) { unsigned r; asm volatile("v_cvt_pk_bf16_f32 %0, %1, %2" : "=v"(r) : "v"(lo), "v"(hi)); return r; }
__device__ __forceinline__ float bf_lo(unsigned v) { return __uint_as_float(v << 16); }
__device__ __forceinline__ float bf_hi(unsigned v) { return __uint_as_float(v & 0xffff0000u); }
__device__ __forceinline__ float wave_sum(float v) {
#pragma unroll
    for (int o = 1; o < 64; o <<= 1) v += __shfl_xor(v, o);
    return v;
}
__device__ __forceinline__ int opaque_tid() { int t = threadIdx.x; asm volatile("" : "+v"(t)); return t; }
__device__ __forceinline__ float fsigmoid(float x) { return __builtin_amdgcn_rcpf(1.0f + __expf(-x)); }
__device__ __forceinline__ float cos_rev(float r) { return __builtin_amdgcn_cosf(r); }
__device__ __forceinline__ float sin_rev(float r) { return __builtin_amdgcn_sinf(r); }


#define XB_TMO      128
#define XB_XCNT(j)  (256  + 64 * (j))
#define XB_XSUB(j)  (1280 + 64 * (j))
#define XB_XGEN(j)  (2304 + 64 * (j))
#define XB_TOP      3328
#define XB_TOPGEN   3392
#define XCD_BAR_WORDS 3456
#define XB_SPIN_CAP (1u << 22)
__device__ __forceinline__ unsigned xb_ld(unsigned* p)              { return __hip_atomic_load(p, __ATOMIC_RELAXED, __HIP_MEMORY_SCOPE_AGENT); }
__device__ __forceinline__ unsigned xb_add(unsigned* p, unsigned v) { return __hip_atomic_fetch_add(p, v, __ATOMIC_RELAXED, __HIP_MEMORY_SCOPE_AGENT); }
__device__ __forceinline__ unsigned xb_xcc_id() { return (unsigned)__builtin_amdgcn_s_getreg((3 << 11) | 20) & 0xFu; }
#define XB_SPIN(cond, bar) do { unsigned _sp = 0; while (cond) { __builtin_amdgcn_s_sleep(1); \
    if ((++_sp & 255u) == 0u) { if (xb_ld(&(bar)[XB_TMO])) break; if (_sp > XB_SPIN_CAP) { atomicAdd(&(bar)[XB_TMO], 1u); break; } } } } while (0)
struct XcdBarrier { unsigned* bar; unsigned x; volatile LAS unsigned* st; };
__device__ __forceinline__ XcdBarrier xcd_barrier_post(unsigned* bar, volatile LAS unsigned* st) {
    XcdBarrier b; b.bar = bar; b.x = xb_xcc_id(); b.st = st;
    if (threadIdx.x == 0) (void)xb_add(&bar[XB_XCNT(b.x)], 1u);
    return b;
}
__device__ __forceinline__ void xcd_barrier_complete(unsigned* bar, unsigned x, unsigned& nloc, unsigned& nx) {
    const unsigned G = gridDim.x * gridDim.y * gridDim.z;
    unsigned sum, cnt, mine, sp = 0u;
    for (;;) {
        sum = 0u; cnt = 0u; mine = 0u;
        unsigned cc[16];
        {
            const unsigned* cb = &bar[XB_XCNT(0)];
            asm volatile(
                "global_load_dword %0, %16, off sc1\n\t"            "global_load_dword %1, %16, off offset:256 sc1\n\t"
                "global_load_dword %2, %16, off offset:512 sc1\n\t" "global_load_dword %3, %16, off offset:768 sc1\n\t"
                "global_load_dword %4, %16, off offset:1024 sc1\n\t" "global_load_dword %5, %16, off offset:1280 sc1\n\t"
                "global_load_dword %6, %16, off offset:1536 sc1\n\t" "global_load_dword %7, %16, off offset:1792 sc1\n\t"
                "global_load_dword %8, %16, off offset:2048 sc1\n\t" "global_load_dword %9, %16, off offset:2304 sc1\n\t"
                "global_load_dword %10, %16, off offset:2560 sc1\n\t" "global_load_dword %11, %16, off offset:2816 sc1\n\t"
                "global_load_dword %12, %16, off offset:3072 sc1\n\t" "global_load_dword %13, %16, off offset:3328 sc1\n\t"
                "global_load_dword %14, %16, off offset:3584 sc1\n\t" "global_load_dword %15, %16, off offset:3840 sc1\n\t"
                "s_waitcnt vmcnt(0)"
                : "=&v"(cc[0]), "=&v"(cc[1]), "=&v"(cc[2]), "=&v"(cc[3]), "=&v"(cc[4]), "=&v"(cc[5]), "=&v"(cc[6]), "=&v"(cc[7]),
                  "=&v"(cc[8]), "=&v"(cc[9]), "=&v"(cc[10]), "=&v"(cc[11]), "=&v"(cc[12]), "=&v"(cc[13]), "=&v"(cc[14]), "=&v"(cc[15])
                : "v"(cb) : "memory");
        }
#pragma unroll
        for (unsigned j = 0; j < 16; ++j) { const unsigned c = cc[j]; sum += c; cnt += (c > 0u) ? 1u : 0u; mine = (j == x) ? c : mine; }
        if (sum == G) break;
        __builtin_amdgcn_s_sleep(1);
        if ((++sp & 255u) == 0u) { if (xb_ld(&bar[XB_TMO])) break; if (sp > XB_SPIN_CAP) { atomicAdd(&bar[XB_TMO], 1u); break; } }
    }
    nloc = mine > 0u ? mine : 1u; nx = cnt > 0u ? cnt : 1u;
}
__device__ __forceinline__ void xcd_barrier(const XcdBarrier& b) {
    asm volatile("s_waitcnt vmcnt(0)" ::: "memory");
    __syncthreads();
    if (threadIdx.x == 0) {
        unsigned* bar = b.bar;
        __builtin_amdgcn_s_waitcnt(0);
        unsigned nloc = b.st[0], nx = b.st[1];
        if (nloc == 0u) { xcd_barrier_complete(bar, b.x, nloc, nx); b.st[0] = nloc; b.st[1] = nx; }
        const unsigned old = xb_add(&bar[XB_XSUB(b.x)], 1u);
        const unsigned gen = old / nloc;
        if (old + 1u == (gen + 1u) * nloc) {
            __builtin_amdgcn_fence(__ATOMIC_RELEASE, "agent");
            asm volatile("s_waitcnt vmcnt(0)" ::: "memory");
            const unsigned og = xb_add(&bar[XB_TOP], 1u);
            const unsigned tg = og / nx;
            if (og + 1u == (tg + 1u) * nx) xb_add(&bar[XB_TOPGEN], 1u);
            else XB_SPIN(xb_ld(&bar[XB_TOPGEN]) == tg, bar);
            __builtin_amdgcn_fence(__ATOMIC_ACQUIRE, "agent");
            xb_add(&bar[XB_XGEN(b.x)], 1u);
            asm volatile("s_waitcnt vmcnt(0)" ::: "memory");
        } else {
            XB_SPIN(xb_ld(&bar[XB_XGEN(b.x)]) == gen, bar);
            __builtin_amdgcn_fence(__ATOMIC_ACQUIRE, "agent");
            asm volatile("s_waitcnt vmcnt(0)" ::: "memory");
        }
    }
    __syncthreads();
}

namespace pg8 {
constexpr int BM = 256, BK = 64, HALF = 128, HTB = HALF * BK * 2;
__device__ __forceinline__ int lds_byte(int r, int c) { const int st = (r >> 4) * 2 + (c >> 5), rr = r & 15, cc = c & 31, ob = rr * 64 + cc * 2; return st * 1024 + (ob ^ (((ob >> 9) & 1) << 5)); }
__device__ __forceinline__ void stage_rc(int b, int& R, int& C) { const int st = b / 1024, sb = b % 1024, swz = sb ^ (((sb >> 9) & 1) << 5); R = (st >> 1) * 16 + swz / 64; C = (st & 1) * 32 + (swz % 64) / 2; }
__device__ __forceinline__ int perm32(int rho) { const int n = rho >> 4, i = rho & 15; return 8 * (i >> 2) + 4 * n + (i & 3); }

struct Unit { const char* a; const char* b; int nt, kind, pm, pn; };

template <class Epi, class Sched>
__device__ __forceinline__ void gemm_phase(LAS unsigned char* lds, const int lda, const int ldb, const Sched& S, const Epi& E) {
    const int tid = opaque_tid(), wid = __builtin_amdgcn_readfirstlane(tid >> 6), lane = tid & 63, wr = wid >> 2, wc = wid & 3, fr = lane & 15, fq = lane >> 4;
    unsigned voffA[2], voffB[2];
#pragma unroll
    for (int i = 0; i < 2; ++i) { int R, C; stage_rc(tid * 16 + i * 8192, R, C); const int Rb = Epi::PERM ? ((R & ~31) + perm32(R & 31)) : R;
        voffA[i] = (unsigned)(R * lda + C) * 2u; voffB[i] = (unsigned)(Rb * ldb + C) * 2u; }
    const size_t kstep = (size_t)(BK * 2);
    const size_t hstepA = (size_t)HALF * lda * 2, hstepB = (size_t)HALF * ldb * 2;
    const unsigned ldsw = (unsigned)wid * 1024u;
    const int aoff = lds_byte(wr * 64 + fr, fq * 8), boff = lds_byte(wc * 32 + fr, fq * 8);
#define PG8_SA(b, h) (((b) * 2 + (h)) * HTB)
#define PG8_SB(b, h) ((4 + (b) * 2 + (h)) * HTB)
#define PG8_STAGE(bufoff, gbase, voff) do { _Pragma("unroll") for (int _i = 0; _i < 2; ++_i) \
        __builtin_amdgcn_global_load_lds((const unsigned*)((const char*)(gbase) + (voff)[_i]), (LAS unsigned*)(lds + (bufoff) + ldsw + _i * 8192), 16, 0, 0); } while (0)
#define PG8_LDA(dst, b, h) do { _Pragma("unroll") for (int m = 0; m < 4; ++m) _Pragma("unroll") for (int k = 0; k < 2; ++k) dst[m][k] = *(const LAS bf16x8*)(lds + PG8_SA(b, h) + aoff + m * 2048 + k * 1024); } while (0)
#define PG8_LDB(dst, b, h) do { _Pragma("unroll") for (int n = 0; n < 2; ++n) _Pragma("unroll") for (int k = 0; k < 2; ++k) dst[n][k] = *(const LAS bf16x8*)(lds + PG8_SB(b, h) + boff + n * 2048 + k * 1024); } while (0)
#define PG8_MMA(ai, bj, At, Bt) do { __builtin_amdgcn_s_setprio(1); _Pragma("unroll") for (int m = 0; m < 4; ++m) _Pragma("unroll") for (int n = 0; n < 2; ++n) _Pragma("unroll") for (int k = 0; k < 2; ++k) \
        acc[ai][bj][m][n] = __builtin_amdgcn_mfma_f32_16x16x32_bf16(Bt[n][k], At[m][k], acc[ai][bj][m][n], 0, 0, 0); __builtin_amdgcn_s_setprio(0); } while (0)
#define PG8_WAIT_V(n) asm volatile("s_waitcnt vmcnt(" #n ")" ::: "memory")
#define PG8_WAIT_L(n) asm volatile("s_waitcnt lgkmcnt(" #n ")" ::: "memory")
#define PG8_BAR __builtin_amdgcn_s_barrier()
#define PG8_SCHED __builtin_amdgcn_sched_barrier(0)
    Unit cur, nxt; int ui = 0;
    if (!S.next(0, cur)) return;
    f32x4 acc[2][2][4][2];
#pragma unroll
    for (int a = 0; a < 2; ++a)
#pragma unroll
        for (int b = 0; b < 2; ++b)
#pragma unroll
            for (int m = 0; m < 4; ++m)
#pragma unroll
                for (int n = 0; n < 2; ++n) acc[a][b][m][n] = (f32x4){0.f, 0.f, 0.f, 0.f};
    bf16x8 At[4][2], B0[2][2], B1[2][2];
    const char* cA = cur.a; const char* cB = cur.b;
    PG8_STAGE(PG8_SB(0, 0), cB, voffB); PG8_STAGE(PG8_SA(0, 0), cA, voffA); PG8_STAGE(PG8_SB(0, 1), cB + hstepB, voffB); PG8_STAGE(PG8_SA(0, 1), cA + hstepA, voffA);
    PG8_STAGE(PG8_SB(1, 0), cB + kstep, voffB); PG8_STAGE(PG8_SA(1, 0), cA + kstep, voffA); PG8_STAGE(PG8_SB(1, 1), cB + hstepB + kstep, voffB);
    if (wr == 1) PG8_BAR;
    PG8_WAIT_V(10); PG8_BAR;
    PG8_WAIT_V(6); PG8_BAR;
    for (;;) {
        const bool has_next = S.next(ui + 1, nxt);
        const char* nA = has_next ? nxt.a : cA; const char* nB = has_next ? nxt.b : cB;
        const int nt = cur.nt;
        for (int t = 0; t < nt; t += 2) {
            const bool last = (t == nt - 2);
            const char* a1 = cA + (size_t)(t + 1) * kstep;
            const char* a2 = last ? nA : cA + (size_t)(t + 2) * kstep; const char* b2 = last ? nB : cB + (size_t)(t + 2) * kstep;
            const char* a3 = a2 + kstep; const char* b3 = b2 + kstep;
            PG8_LDB(B0, 0, 0); PG8_SCHED; PG8_LDA(At, 0, 0); PG8_STAGE(PG8_SA(1, 1), a1 + hstepA, voffA);
            PG8_WAIT_L(8); PG8_BAR; PG8_WAIT_L(0); PG8_MMA(0, 0, At, B0); PG8_BAR; PG8_SCHED;
            PG8_LDB(B1, 0, 1); PG8_STAGE(PG8_SB(0, 0), b2, voffB);
            PG8_BAR; PG8_WAIT_L(0); PG8_MMA(0, 1, At, B1); PG8_BAR;
            PG8_LDA(At, 0, 1); PG8_STAGE(PG8_SA(0, 0), a2, voffA);
            PG8_BAR; PG8_WAIT_L(0); PG8_MMA(1, 0, At, B0); PG8_BAR; PG8_SCHED;
            PG8_STAGE(PG8_SB(0, 1), b2 + hstepB, voffB);
            PG8_WAIT_V(6); PG8_BAR; PG8_MMA(1, 1, At, B1); PG8_BAR;
            PG8_LDB(B0, 1, 0); PG8_SCHED; PG8_LDA(At, 1, 0); PG8_STAGE(PG8_SA(0, 1), a2 + hstepA, voffA);
            PG8_WAIT_L(8); PG8_BAR; PG8_WAIT_L(0); PG8_MMA(0, 0, At, B0); PG8_BAR; PG8_SCHED;
            PG8_LDB(B1, 1, 1); PG8_STAGE(PG8_SB(1, 0), b3, voffB);
            PG8_BAR; PG8_WAIT_L(0); PG8_MMA(0, 1, At, B1); PG8_BAR;
            PG8_LDA(At, 1, 1); PG8_STAGE(PG8_SA(1, 0), a3, voffA);
            PG8_BAR; PG8_WAIT_L(0); PG8_MMA(1, 0, At, B0); PG8_BAR; PG8_SCHED;
            PG8_STAGE(PG8_SB(1, 1), b3 + hstepB, voffB);
            PG8_WAIT_V(6); PG8_BAR; PG8_MMA(1, 1, At, B1); PG8_BAR;
        }
        { int lane2; asm volatile("v_mov_b32 %0, %1" : "=v"(lane2) : "v"(lane));
          E(acc, cur, wr, wc, lane2 & 15, lane2 >> 4); }
        if (!has_next) break;
#pragma unroll
        for (int a = 0; a < 2; ++a)
#pragma unroll
            for (int b = 0; b < 2; ++b)
#pragma unroll
                for (int m = 0; m < 4; ++m)
#pragma unroll
                    for (int n = 0; n < 2; ++n) acc[a][b][m][n] = (f32x4){0.f, 0.f, 0.f, 0.f};
        cur = nxt; cA = nA; cB = nB; ++ui;
    }
    PG8_WAIT_V(0);
    if (wr == 0) PG8_BAR;
    PG8_BAR;
#undef PG8_SA
#undef PG8_SB
#undef PG8_STAGE
#undef PG8_LDA
#undef PG8_LDB
#undef PG8_MMA
#undef PG8_WAIT_V
#undef PG8_WAIT_L
#undef PG8_BAR
#undef PG8_SCHED
}
__device__ __forceinline__ int xcd_remap(int wgid, int nwg) { const int q = nwg / 8, r = nwg % 8, xcd = wgid % 8, off = wgid / 8; return (xcd < r ? xcd * (q + 1) : r * (q + 1) + (xcd - r) * q) + off; }
__device__ __forceinline__ void grid_decode(int w, int nM, int nN, int& pm, int& pn) { const int nig = 8 * nN, gid = w / nig, fm = gid * 8, gsz = (nM - fm) < 8 ? (nM - fm) : 8; pm = fm + ((w % nig) % gsz); pn = (w % nig) / gsz; }
}
using pg8::Unit;

enum { K_TFOLD = 0, K_TV = 1, K_NGLU = 2, K_NQ = 3, K_NK = 4 };
struct SchedP2 {
    const char* H; const char* W; int G, c;
    __device__ __forceinline__ bool next(int i, Unit& u) const {
        const int L = i * G + c; if (L >= 720) return false;
        int w = pg8::xcd_remap(L, 720); int pm, pn;
        { const int x = w / 90, j = w - 90 * x; w = j < 36 ? 36 * x + j : 288 + 54 * x + (j - 36); }
        if (w < 288) { pg8::grid_decode(w, 8, 36, pm, pn); u.kind = pm < 4 ? K_TFOLD : K_TV; u.a = W + (size_t)pm * 256 * 4096; u.b = H + (size_t)pn * 256 * 4096; }
        else { w -= 288; pg8::grid_decode(w, 36, 12, pm, pn); pn = (pn % 3) * 4 + pn / 3;
            u.kind = K_NGLU + (pn >> 2); u.a = H + (size_t)pm * 256 * 4096; u.b = W + (size_t)(2048 + pn * 256) * 4096; }
        u.pm = pm; u.pn = pn; u.nt = 32; return true;
    }
};
struct SchedGrid {
    const char* A; const char* B; int lda, ldb, nM, nN, nt, nsplit  , G, c;
    __device__ __forceinline__ bool next(int i, Unit& u) const {
        const int nmain = nM * nN, ntot = nmain + 4 * nN * nsplit;
        const int L = i * G + c; if (L >= ntot) return false;
        if (L < nmain) { const int w = pg8::xcd_remap(L, nmain); int pm, pn; pg8::grid_decode(w, nM, nN, pm, pn);
            u.kind = 0; u.pm = pm; u.pn = pn; u.nt = nt; u.a = A + (size_t)pm * 256 * lda * 2; u.b = B + (size_t)pn * 256 * ldb * 2; }
        else { const int idx = L - nmain, s = idx & 7, rest = idx >> 3, pn = rest % nN, pm = 32 + rest / nN; const int snt = nt >> 3;
            u.kind = 1 + s; u.pm = pm; u.pn = pn; u.nt = snt; u.a = A + (size_t)pm * 256 * lda * 2 + (size_t)s * snt * 128; u.b = B + (size_t)pn * 256 * ldb * 2 + (size_t)s * snt * 128; }
        return true;
    }
};
struct SchedOne { Unit u; __device__ __forceinline__ bool next(int i, Unit& o) const { if (i) return false; o = u; return true; } };

struct EpiP2 {
    static constexpr bool PERM = true;
    unsigned char* ws; int layer;
    __device__ __forceinline__ void operator()(const f32x4 (&acc)[2][2][4][2], const Unit& u, int wr, int wc, int fr, int fq) const {
        if (u.kind == K_TFOLD || u.kind == K_TV) {
#pragma unroll
            for (int ai = 0; ai < 2; ++ai)
#pragma unroll
                for (int m = 0; m < 4; ++m) {
                    const int rr = 128 * ai + 64 * wr + 16 * m + fr;
#pragma unroll
                    for (int bj = 0; bj < 2; ++bj) {
                        const int tok = 256 * u.pn + 128 * bj + 32 * wc + 8 * fq;
                        const f32x4 v0 = acc[ai][bj][m][0], v1 = acc[ai][bj][m][1];
                        u32x4 w; w.x = pk2(v0[0], v0[1]); w.y = pk2(v0[2], v0[3]); w.z = pk2(v1[0], v1[1]); w.w = pk2(v1[2], v1[3]);
                        const bool lat = tok < NLAT; const int t2 = tok - NLAT;
                        const int b = lat ? (tok >> 11) : (t2 >> 8), pos = lat ? (tok & 2047) : (t2 & 255);
                        bf16_t* dst;
                        if (u.kind == K_TFOLD) { const int g = u.pm, cs = rr >> 7, e = rr & 127;
                            dst = lat ? (bf16_t*)(ws + O_ABT) + (size_t)(g * 128 + e) * 16384 + b * 4096 + cs * 2048 + pos
                                      : (bf16_t*)(ws + O_ABTC) + (size_t)(g * 128 + e) * 2048 + b * 512 + cs * 256 + pos; }
                        else { const int n2 = 256 * (u.pm - 4) + rr, h = n2 >> 7, e = n2 & 127;
                            dst = (bf16_t*)(ws + O_VT) + ((size_t)(b * NH + h) * 128 + e) * LK + (lat ? 256 + pos : pos); }
                        *(u32x4*)dst = w;
                    }
                }
        } else {
            const float* rope = (const float*)(ws + O_ROPE);
            float kmx0 = 0.f, kmx1 = 0.f;
            const int pnl = u.pn & 3;
            if (u.kind == K_NGLU) {
#pragma unroll
                for (int ai = 0; ai < 2; ++ai)
#pragma unroll
                    for (int m = 0; m < 4; ++m) {
                        const int tok = 256 * u.pm + 128 * ai + 64 * wr + 16 * m + fr;
#pragma unroll
                        for (int bj = 0; bj < 2; ++bj) {
                            const f32x4 v0 = acc[ai][bj][m][0], v1 = acc[ai][bj][m][1];
                            const int cl = 256 * pnl + 128 * bj + 32 * wc + 8 * fq;
                            u32x2 w; w.x = pk2(v0[0] * fsigmoid(v1[0]), v0[1] * fsigmoid(v1[1])); w.y = pk2(v0[2] * fsigmoid(v1[2]), v0[3] * fsigmoid(v1[3]));
                            *(u32x2*)((bf16_t*)(ws + O_Z) + (size_t)tok * 512 + (cl >> 1)) = w;
                        }
                    }
            } else {
                const int d1 = ((wc & 1) * 4 + fq) * 4;
                f32x4 rc[2][4], rs[2][4];
#pragma unroll
                for (int ai = 0; ai < 2; ++ai)
#pragma unroll
                    for (int m = 0; m < 4; ++m) { const int tok = 256 * u.pm + 128 * ai + 64 * wr + 16 * m + fr;
                        const float* rp = rope + (size_t)(tok < NLAT ? (tok & 2047) : 0) * 64 + d1;
                        rc[ai][m] = *(const f32x4*)rp; rs[ai][m] = *(const f32x4*)(rp + 32); }
#pragma unroll
                for (int ai = 0; ai < 2; ++ai)
#pragma unroll
                    for (int m = 0; m < 4; ++m) {
                        const int tok = 256 * u.pm + 128 * ai + 64 * wr + 16 * m + fr;
                        const bool lat = tok < NLAT; const int t2 = tok - NLAT;
                        const int b = lat ? (tok >> 11) : (t2 >> 8), pos = lat ? (tok & 2047) : (t2 & 255);
                        const f32x4 cs = lat ? rc[ai][m] : (f32x4){1.f, 1.f, 1.f, 1.f}, sn = lat ? rs[ai][m] : (f32x4){0.f, 0.f, 0.f, 0.f};
#pragma unroll
                        for (int bj = 0; bj < 2; ++bj) {
                            const f32x4 v0 = acc[ai][bj][m][0], v1 = acc[ai][bj][m][1];
                            const int blk = 4 * pnl + 2 * bj + (wc >> 1);
                            f32x4 o1 = v0 * cs - v1 * sn, o2 = v1 * cs + v0 * sn;
                            if (u.kind == K_NQ) { o1 = o1 * QSCALE; o2 = o2 * QSCALE;
                                bf16_t* dst = (bf16_t*)(ws + O_Q) + (size_t)tok * 1024 + blk * 64 + d1;
                                u32x2 w1, w2; w1.x = pk2(o1[0], o1[1]); w1.y = pk2(o1[2], o1[3]); w2.x = pk2(o2[0], o2[1]); w2.y = pk2(o2[2], o2[3]);
                                *(u32x2*)dst = w1; *(u32x2*)(dst + 32) = w2;
                            } else {
                                const int key = lat ? 256 + pos : pos;
                                { float ps = (o1[0] * o1[0] + o1[1] * o1[1]) + (o1[2] * o1[2] + o1[3] * o1[3]) + (o2[0] * o2[0] + o2[1] * o2[1]) + (o2[2] * o2[2] + o2[3] * o2[3]);
                                  ps += __shfl_xor(ps, 16); ps += __shfl_xor(ps, 32);
                                  if (bj == 0) kmx0 = fmaxf(kmx0, ps); else kmx1 = fmaxf(kmx1, ps); }
                                bf16_t* dst = (bf16_t*)(ws + O_KK) + ((size_t)(b * 16 + blk) * LK + key) * 64 + d1;
                                u32x2 w1, w2; w1.x = pk2(o1[0], o1[1]); w1.y = pk2(o1[2], o1[3]); w2.x = pk2(o2[0], o2[1]); w2.y = pk2(o2[2], o2[3]);
                                *(u32x2*)dst = w1; *(u32x2*)(dst + 32) = w2;
                            }
                        }
                    }
            }
            if (u.kind == K_NK) {
#pragma unroll
                for (int o = 1; o < 16; o <<= 1) { kmx0 = fmaxf(kmx0, __shfl_xor(kmx0, o)); kmx1 = fmaxf(kmx1, __shfl_xor(kmx1, o)); }
                const int tok0 = 256 * u.pm; const int b = tok0 < NLAT ? (tok0 >> 11) : ((tok0 - NLAT) >> 8);
                const int blk0 = 4 * (u.pn & 3) + (wc >> 1);
                if (fr == 0 && fq == 0) { unsigned* km = (unsigned*)(ws + O_KMAX) + layer * 64 + b * 16 + blk0;
                    atomicMax(km, __float_as_uint(2.0f * kmx0)); atomicMax(km + 2, __float_as_uint(2.0f * kmx1)); }
            }
        }
    }
};
struct EpiY {
    static constexpr bool PERM = true;
    bf16_t* Y; bf16_t* YP; size_t split_stride;
    __device__ __forceinline__ void operator()(const f32x4 (&acc)[2][2][4][2], const Unit& u, int wr, int wc, int fr, int fq) const {
        const int row0 = wr * 64 + fr, col0 = u.pn * 256 + wc * 32 + 8 * fq;
        bf16_t* base = u.kind == 0 ? Y + (size_t)u.pm * 256 * D : YP + (size_t)(u.kind - 1) * split_stride + (size_t)(u.pm - 32) * 256 * D;
#pragma unroll
        for (int ai = 0; ai < 2; ++ai)
#pragma unroll
            for (int m = 0; m < 4; ++m) { bf16_t* rowp = base + (size_t)(row0 + ai * 128 + m * 16) * D + col0;
#pragma unroll
                for (int bj = 0; bj < 2; ++bj) { const f32x4 v0 = acc[ai][bj][m][0], v1 = acc[ai][bj][m][1];
                    u32x4 w; w.x = pk2(v0[0], v0[1]); w.y = pk2(v0[2], v0[3]); w.z = pk2(v1[0], v1[1]); w.w = pk2(v1[2], v1[3]);
                    *(u32x4*)(rowp + bj * 128) = w; } }
    }
};

template <int ACT  > struct EpiBf16 {
    static constexpr bool PERM = true;
    bf16_t* O; int ldc;
    __device__ __forceinline__ void operator()(const f32x4 (&acc)[2][2][4][2], const Unit& u, int wr, int wc, int fr, int fq) const {
        const int row0 = u.pm * 256 + wr * 64 + fr, col0 = u.pn * 256 + wc * 32 + 8 * fq;
#pragma unroll
        for (int ai = 0; ai < 2; ++ai)
#pragma unroll
            for (int m = 0; m < 4; ++m) { bf16_t* rowp = O + (size_t)(row0 + ai * 128 + m * 16) * ldc + col0;
#pragma unroll
                for (int bj = 0; bj < 2; ++bj) { f32x4 v0 = acc[ai][bj][m][0], v1 = acc[ai][bj][m][1];
                    if (ACT == 1) {
#pragma unroll
                        for (int j = 0; j < 4; ++j) { const float a = fmaxf(v0[j], 0.f), b = fmaxf(v1[j], 0.f); v0[j] = a * a; v1[j] = b * b; } }
                    u32x4 w; w.x = pk2(v0[0], v0[1]); w.y = pk2(v0[2], v0[3]); w.z = pk2(v1[0], v1[1]); w.w = pk2(v1[2], v1[3]);
                    *(u32x4*)(rowp + bj * 128) = w; } }
    }
};

template <class RowMap>
__device__ __forceinline__ void tr_tile(const float* src, int ldn, int k0, int n0, bf16_t* dst, int ldk, int kdst0, const RowMap& rm, LAS float* scr) {
    const int tid = opaque_tid();
    f32x4 v[8];
#pragma unroll
    for (int i = 0; i < 8; ++i) { const int idx = tid + 512 * i, kk = idx >> 4, c = (idx & 15) * 4; v[i] = *(const f32x4*)(src + (size_t)(k0 + kk) * ldn + n0 + c); }
#pragma unroll
    for (int i = 0; i < 8; ++i) { const int idx = tid + 512 * i, kk = idx >> 4, c = (idx & 15) * 4;
        scr[kk * 65 + c] = v[i][0]; scr[kk * 65 + c + 1] = v[i][1]; scr[kk * 65 + c + 2] = v[i][2]; scr[kk * 65 + c + 3] = v[i][3]; }
    __syncthreads();
    { const int n = tid >> 3, kc = tid & 7; bf16_t* drow = dst + (size_t)rm(n0 + n) * ldk + kdst0 + kc * 8;
        float tv[4][8];
#pragma unroll
        for (int hf = 0; hf < 4; ++hf) { const LAS float* s = scr + (hf * 64 + kc * 8) * 65 + n;
#pragma unroll
            for (int j = 0; j < 8; ++j) tv[hf][j] = s[j * 65]; }
#pragma unroll
        for (int hf = 0; hf < 4; ++hf) {
            u32x4 o; o.x = pk2(tv[hf][0], tv[hf][1]); o.y = pk2(tv[hf][2], tv[hf][3]); o.z = pk2(tv[hf][4], tv[hf][5]); o.w = pk2(tv[hf][6], tv[hf][7]);
            *(u32x4*)(drow + hf * 64) = o; } }
    __syncthreads();
}
struct RmId { __device__ __forceinline__ int operator()(int n) const { return n; } };
struct RmWin {
    __device__ __forceinline__ int operator()(int n) const {
        if (n < 1536) { const int x = n - 512, ch = x & 511, gate = x >> 9; return 2048 + (ch >> 2) * 8 + gate * 4 + (ch & 3); }
        if (n < 3584) { const int x = n - 1536, blk = x >> 6, d = x & 63; return 3072 + blk * 64 + ((d & 31) >> 2) * 8 + (d >> 5) * 4 + (d & 3); }
        return 1024 + (n - 3584);
    }
};

__device__ __forceinline__ void phase_prep(const Params& p, LAS unsigned char* lds) {
    const int tid = opaque_tid(), G = gridDim.x;
    unsigned char* ws = p.ws;
    LAS float* scr = (LAS float*)lds;
    constexpr int I_ADA = 768, I_TRL = 512 + 256 + 1024 + 1024, I_TR = 2 * I_TRL;
    constexpr int I_WINF = 640, I_WPW = 128, I_DFT = 0, I_DFTC = 32, I_ROPE = 16, I_MT = 128, I_BO = 32, I_MISC = 1;
    constexpr int NIT = I_ADA + I_TR + I_WINF + I_WPW + I_DFT + I_DFTC + I_ROPE + I_MT + I_BO + I_MISC;
    bool sc_ready = false;
    for (int it = blockIdx.x; it < NIT; it += G) {
        int r = it < I_MT + I_BO + I_MISC ? NIT - (I_MT + I_BO + I_MISC) + it : it - (I_MT + I_BO + I_MISC);
        if (r < I_ADA) {
            const int l = r / 384, n0 = (r % 384) * 32;
            LAS float* sc = scr;
            if (!sc_ready) { for (int i = tid; i < 5 * 2048; i += NTHR) { const int bi = i >> 11, k = i & 2047; const float v = bi < 4 ? p.c[bi * 2048 + k] : p.c_ctx[k]; sc[i] = v * fsigmoid(v); } sc_ready = true; }
            __syncthreads();
            const int kg = tid >> 3, c4 = (tid & 7) * 4;
            f32x4 a[5];
#pragma unroll
            for (int bi = 0; bi < 5; ++bi) a[bi] = (f32x4){0.f, 0.f, 0.f, 0.f};
            const float* W = p.w_ada + (size_t)l * 2048 * 12288 + n0 + c4;
#pragma unroll 1
            for (int i0 = 0; i0 < 32; i0 += 8) {
                f32x4 w[8];
#pragma unroll
                for (int u = 0; u < 8; ++u) w[u] = *(const f32x4*)(W + (size_t)(kg + 64 * (i0 + u)) * 12288);
#pragma unroll
                for (int u = 0; u < 8; ++u) { const int k = kg + 64 * (i0 + u);
#pragma unroll
                    for (int bi = 0; bi < 5; ++bi) a[bi] += w[u] * sc[bi * 2048 + k]; } }
            LAS float* red = scr + 5 * 2048;
#pragma unroll
            for (int bi = 0; bi < 5; ++bi)
#pragma unroll
                for (int j = 0; j < 4; ++j) red[(kg * 8 + (tid & 7)) * 20 + bi * 4 + j] = a[bi][j];
            __syncthreads();
            if (tid < 160) { const int cl = tid / 20, q = tid % 20; float s = 0.f; for (int g = 0; g < 64; ++g) s += red[(g * 8 + cl) * 20 + q];
                const int bi = q >> 2, j = q & 3, n = n0 + cl * 4 + j;
                ((float*)(ws + O_MOD))[(size_t)(l * 5 + bi) * 12288 + n] = s + p.b_ada[l * 12288 + n]; }
            __syncthreads();
            continue;
        }
        r -= I_ADA; sc_ready = false;
        if (r < I_TR) {
            const int l = r / I_TRL; int q = r % I_TRL;
            if (q < 512) { const int kt = q >> 6, ntile = q & 63; tr_tile(p.w_in + (size_t)l * 2048 * INC, INC, kt * 256, 512 + ntile * 64, (bf16_t*)(ws + O_WINT + l * SZ_WINT), 2048, kt * 256, RmWin(), scr); continue; }
            q -= 512;
            if (q < 256) { const int kt = q >> 5, ntile = q & 31; const int k0 = kt * 256;
                if (k0 >= 512 && k0 < 1024) tr_tile(p.w_out + (size_t)l * 2048 * 2048, 2048, k0, ntile * 64, (bf16_t*)(ws + O_WTMP + l * SZ_WTMP), 512, k0 - 512, RmId(), scr);
                else tr_tile(p.w_out + (size_t)l * 2048 * 2048, 2048, k0, ntile * 64, (bf16_t*)(ws + O_WOUTF + l * SZ_WOUTF), 2048, k0, RmId(), scr);
                continue; }
            q -= 256;
            if (q < 1024) { const int kt = q >> 7, ntile = q & 127; tr_tile(p.w_mlp_in + (size_t)l * 2048 * 8192, 8192, kt * 256, ntile * 64, (bf16_t*)(ws + O_WMI + l * SZ_WMI), 2048, kt * 256, RmId(), scr); continue; }
            q -= 1024;
            { const int kt = q >> 5, ntile = q & 31; tr_tile(p.w_mlp_out + (size_t)l * 8192 * 2048, 2048, kt * 256, ntile * 64, (bf16_t*)(ws + O_WMO + l * SZ_WMO), 8192, kt * 256, RmId(), scr); continue; }
        }
        r -= I_TR;
        if (r < I_WINF) {
            const size_t e0 = (size_t)r * 4096 + (size_t)tid * 8; const int l = (int)(e0 / (2048 * 640)); const size_t x = e0 % (2048 * 640); const int k = (int)(x / 640), c = (int)(x % 640);
            u32x4 o = (u32x4){0u, 0u, 0u, 0u};
            if (c < 512) { const float* s = p.w_in + ((size_t)l * 2048 + k) * INC + c; const f32x4 a = *(const f32x4*)s, b = *(const f32x4*)(s + 4);
                o.x = pk2(a[0], a[1]); o.y = pk2(a[2], a[3]); o.z = pk2(b[0], b[1]); o.w = pk2(b[2], b[3]); }
            *(u32x4*)((bf16_t*)(ws + O_WINF) + e0) = o; continue;
        }
        r -= I_WINF;
        if (r < I_WPW) { const size_t e0 = (size_t)r * 4096 + (size_t)tid * 8; const float* s = p.w_conv_pw + e0; const f32x4 a = *(const f32x4*)s, b = *(const f32x4*)(s + 4);
            u32x4 o; o.x = pk2(a[0], a[1]); o.y = pk2(a[2], a[3]); o.z = pk2(b[0], b[1]); o.w = pk2(b[2], b[3]); *(u32x4*)((bf16_t*)(ws + O_WPW) + e0) = o; continue; }
        r -= I_WPW;
        if (r < I_DFT) {
            const size_t e0 = (size_t)r * 4096 + (size_t)tid * 8; const int j = (int)(e0 >> 12), k0 = (int)(e0 & 4095);
            float v[8];
#pragma unroll
            for (int i = 0; i < 8; ++i) { const int k = k0 + i, kk = k & 2047; const float rev = (float)((j * kk) & 2047) * (1.0f / 2048.0f);
                v[i] = (k < 2048 ? cos_rev(rev) : -sin_rev(rev)) * 0.02209708691207961f; }
            u32x4 o; o.x = pk2(v[0], v[1]); o.y = pk2(v[2], v[3]); o.z = pk2(v[4], v[5]); o.w = pk2(v[6], v[7]); *(u32x4*)((bf16_t*)(ws + O_DFT) + e0) = o; continue;
        }
        r -= I_DFT;
        if (r < I_DFTC) {
            const size_t e0 = (size_t)r * 4096 + (size_t)tid * 8; const int j = (int)(e0 >> 9), k0 = (int)(e0 & 511);
            float v[8];
#pragma unroll
            for (int i = 0; i < 8; ++i) { const int k = k0 + i, kk = k & 255; const float rev = (float)((j * kk) & 255) * (1.0f / 256.0f);
                v[i] = (k < 256 ? cos_rev(rev) : -sin_rev(rev)) * 0.0625f; }
            u32x4 o; o.x = pk2(v[0], v[1]); o.y = pk2(v[2], v[3]); o.z = pk2(v[4], v[5]); o.w = pk2(v[6], v[7]); *(u32x4*)((bf16_t*)(ws + O_DFTC) + e0) = o; continue;
        }
        r -= I_DFTC;
        if (r < I_ROPE) {
#pragma unroll
            for (int i = 0; i < 8; ++i) { const int e = r * 4096 + i * 512 + tid, pos = e >> 5, f = e & 31;
                const float inv = exp2f(-(float)(f & 15) * (13.287712379549449f / 16.0f));
                const float ang = (float)(f < 16 ? (pos >> 6) : (pos & 63)) * inv;
                float rev = ang * 0.15915494309189535f; rev -= floorf(rev);
                float* o = (float*)(ws + O_ROPE) + (size_t)pos * 64 + f; o[0] = cos_rev(rev); o[32] = sin_rev(rev); }
            continue;
        }
        r -= I_ROPE;
        if (r < I_MT) {
            const int l = r >> 6, g = (r >> 4) & 3, cs = (r >> 3) & 1, cq = r & 7;
            const float* Wf = p.w_fourier + (size_t)(l * 4 + g) * 128 * 128;
            LAS float* sw = scr;
            LAS float* tb = scr + 128 * 128;
            for (int i = tid; i < 128 * 128; i += NTHR) sw[i] = Wf[i];
            if (tid < 128) { const float rev = (float)tid * (1.0f / 128.0f); tb[tid] = (cs ? sin_rev(rev) : cos_rev(rev)) * 0.08838834764831845f; }
            __syncthreads();
            bf16_t* dst = (bf16_t*)(ws + O_MTP + l * SZ_MTP) + (size_t)(g * 256 + cs * 128) * 256;
            for (int o = tid; o < 16 * 128; o += NTHR) { const int e = o & 127, c = cq * 16 + (o >> 7); float s = 0.f;
#pragma unroll 8
                for (int c2 = 0; c2 < 128; ++c2) s += tb[(c * c2) & 127] * sw[c2 * 128 + e];
                dst[(size_t)e * 256 + c] = (bf16_t)(pk2(s, 0.f) & 0xffffu); dst[(size_t)e * 256 + 128 + c] = 0; }
            __syncthreads();
            continue;
        }
        r -= I_MT;
        if (r < I_BO) {
            const int l = r >> 4, n = (r & 15) * 128 + (tid & 127), jq = tid >> 7;
            const float* W = p.w_out + ((size_t)l * 2048 + 512 + jq * 128) * 2048 + n; const float* bp = p.b_conv_pw + l * 512 + jq * 128;
            float s = 0.f;
#pragma unroll 1
            for (int j0 = 0; j0 < 128; j0 += 16) { float w[16];
#pragma unroll
                for (int u = 0; u < 16; ++u) w[u] = W[(size_t)(j0 + u) * 2048];
#pragma unroll
                for (int u = 0; u < 16; ++u) s += bp[j0 + u] * w[u]; }
            scr[tid] = s;
            __syncthreads();
            if (tid < 128) ((float*)(ws + O_BO))[l * 2048 + n] = (scr[tid] + scr[tid + 128]) + (scr[tid + 256] + scr[tid + 384]);
            __syncthreads();
            continue;
        }
        r -= I_BO;
        {
            if (tid < 128) { const int l = tid >> 6, i = tid & 63; const float a = wave_sum(p.lq1[l * 64 + i] * p.lk1[l * 64 + i]), b = wave_sum(p.lq2[l * 64 + i] * p.lk2[l * 64 + i]);
                if (i == 0) ((float*)(ws + O_MISC))[l] = __expf(a) - __expf(b) + (0.8f - 0.6f * __expf(-0.3f * (float)l)); }
            if (tid >= 128 && tid < 144) ((unsigned*)(ws + O_MISC))[16 + (tid - 128) * 8] = 0u;
            if (tid >= 256 && tid < 384) ((unsigned*)(ws + O_KMAX))[tid - 256] = 0u;
        }
    }
}

struct RowArgs {
    int mode; bool hasH; int nrows;
    const float* xlat; const float* xctx; float* olat; float* octx;
    const bf16_t* Y; const bf16_t* YP; const float* bias;
    const float* gpost; const float* gn; const float* mod;
    const float* modn; int gate_off, sh_off, sc_off; bf16_t* H;
    const bf16_t* x16; bf16_t* o16; bool in16, out16;
};
__device__ __forceinline__ void phase_rows(const RowArgs& a) {
    const int tid = opaque_tid(), lane = tid & 63, wid = tid >> 6, gw = blockIdx.x * 8 + wid, NW = gridDim.x * 8;
    for (int r = gw; r < a.nrows; r += NW) {
        const bool lat = r < NLAT; const int bi = lat ? (r >> 11) : 4;
        int l4 = lane * 4; asm volatile("" : "+v"(l4));
        const float* xr = (lat ? a.xlat + (size_t)r * D : a.xctx + (size_t)(r - NLAT) * D) + l4;
        f32x4 x[8];
        if (a.in16) { u32x2 w[8];
#pragma unroll
            for (int j = 0; j < 8; ++j) w[j] = *(const u32x2*)(a.x16 + (size_t)r * D + l4 + 256 * j);
#pragma unroll
            for (int j = 0; j < 8; ++j) x[j] = (f32x4){bf_lo(w[j].x), bf_hi(w[j].x), bf_lo(w[j].y), bf_hi(w[j].y)};
        } else {
#pragma unroll
            for (int j = 0; j < 8; ++j) x[j] = *(const f32x4*)(xr + 256 * j);
        }
        if (a.mode == 1) {
            f32x4 y[8];
            if (lat) {
                u32x2 w[8];
#pragma unroll
                for (int j = 0; j < 8; ++j) w[j] = *(const u32x2*)(a.Y + (size_t)r * D + l4 + 256 * j);
#pragma unroll
                for (int j = 0; j < 8; ++j) y[j] = (f32x4){bf_lo(w[j].x), bf_hi(w[j].x), bf_lo(w[j].y), bf_hi(w[j].y)};
            } else {
#pragma unroll
                for (int j = 0; j < 8; ++j) y[j] = (f32x4){0.f, 0.f, 0.f, 0.f};
#pragma unroll 1
                for (int q = 0; q < 8; q += 4) { const bf16_t* yp = a.YP + (size_t)q * NCTX * D + (size_t)(r - NLAT) * D + l4;
                    u32x2 t[4][8];
#pragma unroll
                    for (int qq = 0; qq < 4; ++qq)
#pragma unroll
                        for (int j = 0; j < 8; ++j) t[qq][j] = *(const u32x2*)(yp + (size_t)qq * NCTX * D + 256 * j);
#pragma unroll
                    for (int qq = 0; qq < 4; ++qq)
#pragma unroll
                        for (int j = 0; j < 8; ++j) y[j] += (f32x4){bf_lo(t[qq][j].x), bf_hi(t[qq][j].x), bf_lo(t[qq][j].y), bf_hi(t[qq][j].y)}; }
            }
            if (a.bias) {
                f32x4 bv[8];
#pragma unroll
                for (int j = 0; j < 8; ++j) bv[j] = *(const f32x4*)(a.bias + l4 + 256 * j);
#pragma unroll
                for (int j = 0; j < 8; ++j) y[j] += bv[j]; }
            const float* gate = a.mod + (size_t)bi * 12288 + a.gate_off + l4;
            f32x4 g[8], gp[8];
#pragma unroll
            for (int j = 0; j < 8; ++j) { g[j] = *(const f32x4*)(gate + 256 * j); gp[j] = *(const f32x4*)(a.gpost + l4 + 256 * j); }
            float ss = 0.f;
#pragma unroll
            for (int j = 0; j < 8; ++j) ss += (y[j][0] * y[j][0] + y[j][1] * y[j][1]) + (y[j][2] * y[j][2] + y[j][3] * y[j][3]);
            const float rstd = rsqrtf(wave_sum(ss) * (1.0f / D) + EPS);
#pragma unroll
            for (int j = 0; j < 8; ++j) x[j] = x[j] + g[j] * (y[j] * rstd * gp[j]);
        }
        if (a.hasH) {
            const float* sh = a.modn + (size_t)bi * 12288 + a.sh_off + l4; const float* sc = a.modn + (size_t)bi * 12288 + a.sc_off + l4;
            f32x4 gn[8], s1[8], s2[8];
#pragma unroll
            for (int j = 0; j < 8; ++j) { gn[j] = *(const f32x4*)(a.gn + l4 + 256 * j); s1[j] = *(const f32x4*)(sh + 256 * j); s2[j] = *(const f32x4*)(sc + 256 * j); }
            float ss = 0.f;
#pragma unroll
            for (int j = 0; j < 8; ++j) ss += (x[j][0] * x[j][0] + x[j][1] * x[j][1]) + (x[j][2] * x[j][2] + x[j][3] * x[j][3]);
            const float rstd = rsqrtf(wave_sum(ss) * (1.0f / D) + EPS);
            u32x2 w[8];
#pragma unroll
            for (int j = 0; j < 8; ++j) { const f32x4 h = (x[j] * rstd * gn[j]) * (s2[j] + 1.0f) + s1[j]; w[j].x = pk2(h[0], h[1]); w[j].y = pk2(h[2], h[3]); }
#pragma unroll
            for (int j = 0; j < 8; ++j) *(u32x2*)(a.H + (size_t)r * D + l4 + 256 * j) = w[j];
        }
        if (a.mode == 1) {
            if (a.out16) {
#pragma unroll
                for (int j = 0; j < 8; ++j) { u32x2 w; w.x = pk2(x[j][0], x[j][1]); w.y = pk2(x[j][2], x[j][3]); *(u32x2*)(a.o16 + (size_t)r * D + l4 + 256 * j) = w; }
            } else {
                float* orow = (lat ? a.olat + (size_t)r * D : a.octx + (size_t)(r - NLAT) * D) + l4;
#pragma unroll
                for (int j = 0; j < 8; ++j) *(f32x4*)(orow + 256 * j) = x[j];
            }
        }
    }
}

__device__ __forceinline__ void attn_item(const Params& p, LAS unsigned char* lds, int l, int b, int h, int qb, bool isctx) {
    unsigned char* ws = p.ws;
    const int tid = opaque_tid(), wid = __builtin_amdgcn_readfirstlane(tid >> 6), lane = tid & 63, mm = wid >> 2, rg = wid & 3, qi = lane & 31, hh = lane >> 5;
    const int nt = isctx ? 4 : 36;
    const int qrow = (isctx ? NLAT + b * 256 : b * 2048) + qb * 128 + rg * 32 + qi;
    bf16x8 Bq[4];
    { const bf16_t* Q = (const bf16_t*)(ws + O_Q) + (size_t)qrow * 1024 + h * 128 + mm * 64 + hh * 8;
#pragma unroll
        for (int ks = 0; ks < 4; ++ks) Bq[ks] = *(const bf16x8*)(Q + ks * 16); }
    const char* Kb = (const char*)(ws + O_KK) + (size_t)((b * NH + h) * 2) * LK * 128;
    const char* Vb = (const char*)(ws + O_VT) + (size_t)(b * NH + h) * 128 * LK * 2;
    const int skey = tid >> 3, sch = tid & 7;
    const unsigned koff = (unsigned)(skey * 128 + sch * 16);
    const char* Kb1 = Kb + (size_t)LK * 128;
    const int kdst = skey * 128 + ((sch ^ ((skey >> 1) & 7)) * 16);
    const int e0s = skey, e1s = skey + 64;
    const unsigned voff = (unsigned)(e0s * (LK * 2) + sch * 16); const char* Vb1 = Vb + (size_t)64 * (LK * 2);
    const int vsw = (skey >> 1) & 7;
    const int vdA = (((sch & 6)) ^ vsw) * 16 + (sch & 1) * 8, vdB = (((sch & 6) + 1) ^ vsw) * 16 + (sch & 1) * 8;
    const int vdst0 = e0s * 128, vdst1 = e1s * 128;
    u32x4 rk0, rk1, rv0, rv1;
#define ATT_LOAD(t) do { rk0 = *(const u32x4*)(Kb + (koff + (unsigned)(t) * 8192u)); rk1 = *(const u32x4*)(Kb1 + (koff + (unsigned)(t) * 8192u)); \
        rv0 = *(const u32x4*)(Vb + (voff + (unsigned)(t) * 128u)); rv1 = *(const u32x4*)(Vb1 + (voff + (unsigned)(t) * 128u)); } while (0)
#define ATT_STORE(buf) do { *(LAS u32x4*)(lds + (buf) * 16384 + kdst) = rk0; *(LAS u32x4*)(lds + (buf) * 16384 + 8192 + kdst) = rk1; \
        *(LAS u32x2*)(lds + 32768 + (buf) * 16384 + vdst0 + vdA) = (u32x2){rv0.x, rv0.y}; *(LAS u32x2*)(lds + 32768 + (buf) * 16384 + vdst0 + vdB) = (u32x2){rv0.z, rv0.w}; \
        *(LAS u32x2*)(lds + 32768 + (buf) * 16384 + vdst1 + vdA) = (u32x2){rv1.x, rv1.y}; *(LAS u32x2*)(lds + 32768 + (buf) * 16384 + vdst1 + vdB) = (u32x2){rv1.z, rv1.w}; } while (0)
    f32x16 oacc[4];
#pragma unroll
    for (int et = 0; et < 4; ++et)
#pragma unroll
        for (int r = 0; r < 16; ++r) oacc[et][r] = 0.f;
    float lsum = 0.f, nmref;
    { float qs = 0.f;
#pragma unroll
        for (int ks = 0; ks < 4; ++ks) { const u32x4 w = __builtin_bit_cast(u32x4, Bq[ks]);
#pragma unroll
            for (int j = 0; j < 4; ++j) { const float a = bf_lo(w[j]), c = bf_hi(w[j]); qs += a * a + c * c; } }
        qs += __shfl_xor(qs, 32);
        const float k2 = __uint_as_float(((const unsigned*)(ws + O_KMAX))[l * 64 + b * 16 + h * 2 + mm]);
        nmref = -(sqrtf(qs * k2) * 1.02f + 1e-6f); }
    const int ksw = (qi >> 1) & 7;
    const int kread = mm * 8192 + qi * 128;
    const int vread = 32768 + qi * 128;
    ATT_LOAD(0);
    const u32x4 rk2 = *(const u32x4*)(Kb + (koff + 8192u)), rk3 = *(const u32x4*)(Kb1 + (koff + 8192u));
    { *(LAS u32x4*)(lds + kdst) = rk0; *(LAS u32x4*)(lds + 8192 + kdst) = rk1;
      *(LAS u32x2*)(lds + 32768 + 16384 + vdst0 + vdA) = (u32x2){rv0.x, rv0.y}; *(LAS u32x2*)(lds + 32768 + 16384 + vdst0 + vdB) = (u32x2){rv0.z, rv0.w};
      *(LAS u32x2*)(lds + 32768 + 16384 + vdst1 + vdA) = (u32x2){rv1.x, rv1.y}; *(LAS u32x2*)(lds + 32768 + 16384 + vdst1 + vdB) = (u32x2){rv1.z, rv1.w}; }
    { *(LAS u32x4*)(lds + 16384 + kdst) = rk2; *(LAS u32x4*)(lds + 16384 + 8192 + kdst) = rk3; }
    __syncthreads();
    f32x16 s0, s1;
#pragma unroll
    for (int r = 0; r < 16; ++r) { s0[r] = nmref; s1[r] = nmref; }
#pragma unroll
    for (int ks = 0; ks < 4; ++ks) {
        const int co = ((2 * ks + hh) ^ ksw) * 16;
        const bf16x8 a0 = *(const LAS bf16x8*)(lds + kread + co);
        const bf16x8 a1 = *(const LAS bf16x8*)(lds + kread + 4096 + co);
        s0 = __builtin_amdgcn_mfma_f32_32x32x16_bf16(a0, Bq[ks], s0, 0, 0, 0);
        s1 = __builtin_amdgcn_mfma_f32_32x32x16_bf16(a1, Bq[ks], s1, 0, 0, 0);
    }
    bf16x8 Pf[4];
#pragma unroll
    for (int i = 0; i < 4; ++i) Pf[i] = (bf16x8){0, 0, 0, 0, 0, 0, 0, 0};
    for (int t = 0; t < nt; ++t) {
        const int bk = ((t + 1) & 1) * 16384, bv = ((t + 1) & 1) * 16384;
        rv0 = *(const u32x4*)(Vb + (voff + (unsigned)t * 128u)); rv1 = *(const u32x4*)(Vb1 + (voff + (unsigned)t * 128u));
        if (t + 2 < nt) { rk0 = *(const u32x4*)(Kb + (koff + (unsigned)(t + 2) * 8192u)); rk1 = *(const u32x4*)(Kb1 + (koff + (unsigned)(t + 2) * 8192u)); }
#pragma unroll
        for (int s4 = 0; s4 < 4; ++s4) {
            const int c0 = ((2 * s4 + hh) ^ ksw) * 16;
#pragma unroll
            for (int et = 0; et < 4; ++et) {
                const bf16x8 vv = *(const LAS bf16x8*)(lds + bv + vread + et * 4096 + c0);
                oacc[et] = __builtin_amdgcn_mfma_f32_32x32x16_bf16(vv, Pf[s4], oacc[et], 0, 0, 0);
            }
        }
        f32x16 n0, n1;
#pragma unroll
        for (int r = 0; r < 16; ++r) { n0[r] = nmref; n1[r] = nmref; }
#pragma unroll
        for (int ks = 0; ks < 4; ++ks) {
            const int co = ((2 * ks + hh) ^ ksw) * 16;
            const bf16x8 a0 = *(const LAS bf16x8*)(lds + bk + kread + co);
            const bf16x8 a1 = *(const LAS bf16x8*)(lds + bk + kread + 4096 + co);
            n0 = __builtin_amdgcn_mfma_f32_32x32x16_bf16(a0, Bq[ks], n0, 0, 0, 0);
            n1 = __builtin_amdgcn_mfma_f32_32x32x16_bf16(a1, Bq[ks], n1, 0, 0, 0);
        }
        float ps = 0.f;
#pragma unroll
        for (int r = 0; r < 16; ++r) { s0[r] = __builtin_amdgcn_exp2f(s0[r]); s1[r] = __builtin_amdgcn_exp2f(s1[r]); ps += s0[r] + s1[r]; }
        lsum += ps;
        bf16x8 Pn[4];
#pragma unroll
        for (int s = 0; s < 2; ++s) {
            u32x4 w0, w1;
            w0.x = pk2(s0[8 * s + 0], s0[8 * s + 1]); w0.y = pk2(s0[8 * s + 2], s0[8 * s + 3]); w0.z = pk2(s0[8 * s + 4], s0[8 * s + 5]); w0.w = pk2(s0[8 * s + 6], s0[8 * s + 7]);
            w1.x = pk2(s1[8 * s + 0], s1[8 * s + 1]); w1.y = pk2(s1[8 * s + 2], s1[8 * s + 3]); w1.z = pk2(s1[8 * s + 4], s1[8 * s + 5]); w1.w = pk2(s1[8 * s + 6], s1[8 * s + 7]);
            Pn[s] = __builtin_bit_cast(bf16x8, w0); Pn[2 + s] = __builtin_bit_cast(bf16x8, w1);
        }
#pragma unroll
        for (int i = 0; i < 4; ++i) Pf[i] = Pn[i];
        s0 = n0; s1 = n1;
#pragma unroll
        for (int i = 0; i < 24; ++i) { __builtin_amdgcn_sched_group_barrier(0x008, 1, 0); __builtin_amdgcn_sched_group_barrier(0x002, 7, 0); }
        { const int bo = (t & 1) * 16384;
          *(LAS u32x2*)(lds + 32768 + bo + vdst0 + vdA) = (u32x2){rv0.x, rv0.y}; *(LAS u32x2*)(lds + 32768 + bo + vdst0 + vdB) = (u32x2){rv0.z, rv0.w};
          *(LAS u32x2*)(lds + 32768 + bo + vdst1 + vdA) = (u32x2){rv1.x, rv1.y}; *(LAS u32x2*)(lds + 32768 + bo + vdst1 + vdB) = (u32x2){rv1.z, rv1.w};
          if (t + 2 < nt) { *(LAS u32x4*)(lds + bo + kdst) = rk0; *(LAS u32x4*)(lds + bo + 8192 + kdst) = rk1; } }
        __syncthreads();
    }
    {
        const int bv = ((nt - 1) & 1) * 16384;
#pragma unroll
        for (int s4 = 0; s4 < 4; ++s4) {
            const int c0 = ((2 * s4 + hh) ^ ksw) * 16;
#pragma unroll
            for (int et = 0; et < 4; ++et) {
                const bf16x8 vv = *(const LAS bf16x8*)(lds + bv + vread + et * 4096 + c0);
                oacc[et] = __builtin_amdgcn_mfma_f32_32x32x16_bf16(vv, Pf[s4], oacc[et], 0, 0, 0);
            }
        }
    }
#undef ATT_LOAD
#undef ATT_STORE
    const float ltot = lsum + __shfl_xor(lsum, 32), inv = 1.0f / ltot;
    LAS float* comb = (LAS float*)(lds + 65536);
    if (mm == 1) {
#pragma unroll
        for (int et = 0; et < 4; ++et)
#pragma unroll
            for (int r = 0; r < 16; ++r) comb[(rg * 64 + et * 16 + r) * 64 + lane] = oacc[et][r] * inv;
    }
    __syncthreads();
    if (mm == 0) {
        const float lam = ((const float*)(ws + O_MISC))[l];
        const float post = 1.0f - (0.8f - 0.6f * __expf(-0.3f * (float)l));
        float ss = 0.f;
        float cv[4][16];
#pragma unroll
        for (int et = 0; et < 4; ++et)
#pragma unroll
            for (int r = 0; r < 16; ++r) cv[et][r] = comb[(rg * 64 + et * 16 + r) * 64 + lane];
#pragma unroll
        for (int et = 0; et < 4; ++et)
#pragma unroll
            for (int r = 0; r < 16; ++r) { const float o = oacc[et][r] * inv - lam * cv[et][r]; oacc[et][r] = o; ss += o * o; }
        ss += __shfl_xor(ss, 32);
        const float rstd = rsqrtf(ss * (1.0f / 128.0f) + EPS) * post;
        const float* gs = p.g_subln + l * 128;
        bf16_t* dst = (bf16_t*)(ws + O_CAT) + (size_t)qrow * D + 1024 + h * 128;
        f32x4 g[4][4];
#pragma unroll
        for (int et = 0; et < 4; ++et)
#pragma unroll
            for (int rq = 0; rq < 4; ++rq) g[et][rq] = *(const f32x4*)(gs + 32 * et + 8 * rq + 4 * hh);
        u32x2 w[4][4];
#pragma unroll
        for (int et = 0; et < 4; ++et)
#pragma unroll
            for (int rq = 0; rq < 4; ++rq) { w[et][rq].x = pk2(oacc[et][4 * rq] * rstd * g[et][rq][0], oacc[et][4 * rq + 1] * rstd * g[et][rq][1]);
                w[et][rq].y = pk2(oacc[et][4 * rq + 2] * rstd * g[et][rq][2], oacc[et][4 * rq + 3] * rstd * g[et][rq][3]); }
#pragma unroll
        for (int et = 0; et < 4; ++et)
#pragma unroll
            for (int rq = 0; rq < 4; ++rq) *(u32x2*)(dst + 32 * et + 8 * rq + 4 * hh) = w[et][rq];
    }
    __syncthreads();
}

__device__ __forceinline__ void conv_item(const Params& p, LAS unsigned char* lds, int l, int seq, int tile) {
    unsigned char* ws = p.ws;
    const int tid = opaque_tid(), wid = tid >> 6, lane = tid & 63;
    const bool lat = seq < 4; const int L = lat ? SEQ : CTXL; const int row0 = lat ? seq * SEQ : NLAT + (seq - 4) * CTXL; const int pos0 = tile * 32;
    LAS unsigned* zs = (LAS unsigned*)lds;
    LAS float* co = (LAS float*)(lds + 63488);
    const unsigned* Z = (const unsigned*)(ws + O_Z);
    for (int i = tid; i < 62 * 64; i += NTHR) { const int rr = i >> 6, c4 = (i & 63) * 4; const int pos = pos0 - 15 + rr;
        u32x4 v = (u32x4){0u, 0u, 0u, 0u};
        if (pos >= 0 && pos < L) v = *(const u32x4*)(Z + (size_t)(row0 + pos) * 256 + c4);
        *(LAS u32x4*)(zs + rr * 256 + c4) = v; }
    const int cp = tid & 255, th = tid >> 8;
    float w0[31], w1[31];
    const float* wd = p.w_dw + (size_t)l * 31 * 512 + 2 * cp;
#pragma unroll
    for (int j = 0; j < 31; ++j) { w0[j] = wd[j * 512]; w1[j] = wd[j * 512 + 1]; }
    const float b0 = p.b_dw[l * 512 + 2 * cp], b1 = p.b_dw[l * 512 + 2 * cp + 1];
    __syncthreads();
    for (int i = 0; i < 16; ++i) { const int tt = th * 16 + i; float a0 = b0, a1 = b1;
#pragma unroll
        for (int j = 0; j < 31; ++j) { const unsigned v = zs[(tt + j) * 256 + cp]; a0 += w0[j] * bf_lo(v); a1 += w1[j] * bf_hi(v); }
        co[tt * 512 + 2 * cp] = a0; co[tt * 512 + 2 * cp + 1] = a1; }
    __syncthreads();
    const float* gl = p.g_conv_ln + l * 512 + lane * 8; const float* bl = p.b_conv_ln + l * 512 + lane * 8;
    for (int q = 0; q < 4; ++q) { const int tt = wid * 4 + q;
        float v[8]; float s = 0.f;
#pragma unroll
        for (int j = 0; j < 8; ++j) { v[j] = co[tt * 512 + lane * 8 + j]; s += v[j]; }
        const float mean = wave_sum(s) * (1.0f / 512.0f); float s2 = 0.f;
#pragma unroll
        for (int j = 0; j < 8; ++j) { v[j] -= mean; s2 += v[j] * v[j]; }
        const float rstd = rsqrtf(wave_sum(s2) * (1.0f / 512.0f) + EPS);
#pragma unroll
        for (int j = 0; j < 8; ++j) { const float y = v[j] * rstd * gl[j] + bl[j]; v[j] = y * fsigmoid(y); }
        u32x4 o; o.x = pk2(v[0], v[1]); o.y = pk2(v[2], v[3]); o.z = pk2(v[4], v[5]); o.w = pk2(v[6], v[7]);
        *(u32x4*)((bf16_t*)(ws + O_CAT) + (size_t)(row0 + pos0 + tt) * D + 512 + lane * 8) = o; }
    __syncthreads();
}


typedef float f32x2 __attribute__((ext_vector_type(2)));
__device__ __forceinline__ f32x2 cmul(f32x2 a, f32x2 w) { return (f32x2){a.x * w.x - a.y * w.y, a.x * w.y + a.y * w.x}; }
__device__ __forceinline__ f32x2 tw_rev(float f) { return (f32x2){cos_rev(f), -sin_rev(f)}; }
__device__ __forceinline__ void fft4(f32x2& a0, f32x2& a1, f32x2& a2, f32x2& a3) {
    const f32x2 t0 = a0 + a2, t1 = a0 - a2, t2 = a1 + a3, d = a1 - a3; const f32x2 t3 = (f32x2){d.y, -d.x};
    a0 = t0 + t2; a1 = t1 + t3; a2 = t0 - t2; a3 = t1 - t3;
}
__device__ __forceinline__ void fft16(f32x2 (&v)[16], f32x2 (&o)[16]) {
    constexpr float C1 = 0.9238795325112867f, S1 = 0.3826834323650898f, C2 = 0.7071067811865476f;
#pragma unroll
    for (int n1 = 0; n1 < 4; ++n1) fft4(v[n1], v[n1 + 4], v[n1 + 8], v[n1 + 12]);
    v[5] = cmul(v[5], (f32x2){C1, -S1}); v[9] = cmul(v[9], (f32x2){C2, -C2}); v[13] = cmul(v[13], (f32x2){S1, -C1});
    v[6] = cmul(v[6], (f32x2){C2, -C2}); v[10] = (f32x2){v[10].y, -v[10].x}; v[14] = cmul(v[14], (f32x2){-C2, -C2});
    v[7] = cmul(v[7], (f32x2){S1, -C1}); v[11] = cmul(v[11], (f32x2){-C2, -C2}); v[15] = cmul(v[15], (f32x2){-C1, S1});
#pragma unroll
    for (int p = 0; p < 4; ++p) { fft4(v[4 * p], v[4 * p + 1], v[4 * p + 2], v[4 * p + 3]);
        o[p] = v[4 * p]; o[4 + p] = v[4 * p + 1]; o[8 + p] = v[4 * p + 2]; o[12 + p] = v[4 * p + 3]; }
}
__device__ __forceinline__ void fft8(f32x2 (&v)[8], f32x2 (&o)[8]) {
    constexpr float C2 = 0.7071067811865476f;
    f32x2 s0 = v[0] + v[4], s1 = v[1] + v[5], s2 = v[2] + v[6], s3 = v[3] + v[7];
    f32x2 d0 = v[0] - v[4], d1 = cmul(v[1] - v[5], (f32x2){C2, -C2}), d2 = v[2] - v[6], d3 = cmul(v[3] - v[7], (f32x2){-C2, -C2});
    d2 = (f32x2){d2.y, -d2.x};
    fft4(s0, s1, s2, s3); fft4(d0, d1, d2, d3);
    o[0] = s0; o[2] = s1; o[4] = s2; o[6] = s3; o[1] = d0; o[3] = d1; o[5] = d2; o[7] = d3;
}
__device__ __forceinline__ void fft_item(const Params& p, LAS unsigned char* lds, int b, int n0) {
    unsigned char* ws = p.ws;
    const int tid = opaque_tid();
    constexpr int CS = 2176;
    LAS f32x2* Z = (LAS f32x2*)lds;
    const bf16_t* AB = (const bf16_t*)(ws + O_ABT);
#pragma unroll
    for (int i = 0; i < 2; ++i) { const int ch = tid + 512 * i, col = ch >> 8, pc = ch & 255;
        const bf16_t* src = AB + (size_t)(n0 + col) * 16384 + b * 4096 + pc * 8;
        const u32x4 a = *(const u32x4*)src, bb = *(const u32x4*)(src + 2048);
        LAS f32x2* d = Z + col * CS + pc * 8 + (pc >> 1);
#pragma unroll
        for (int q = 0; q < 4; ++q) { d[2 * q] = (f32x2){bf_lo(a[q]), -bf_lo(bb[q])}; d[2 * q + 1] = (f32x2){bf_hi(a[q]), -bf_hi(bb[q])}; } }
    __syncthreads();
    const int col = tid >> 7, j = tid & 127;
    LAS f32x2* Zc = Z + col * CS;
    f32x2 v[16], o[16];
#pragma unroll
    for (int r = 0; r < 16; ++r) { const int i = j + 128 * r; v[r] = Zc[i + (i >> 4)]; }
    fft16(v, o);
    __syncthreads();
#pragma unroll
    for (int q = 0; q < 16; ++q) Zc[17 * j + q] = o[q];
    __syncthreads();
    { const int k = j & 15;
#pragma unroll
        for (int r = 0; r < 16; ++r) { const int i = j + 128 * r; v[r] = Zc[i + (i >> 4)]; if (r) v[r] = cmul(v[r], tw_rev((float)(r * k) * (1.0f / 256.0f))); }
        fft16(v, o);
        __syncthreads();
        const int base = (j >> 4) * 256 + k;
#pragma unroll
        for (int q = 0; q < 16; ++q) { const int i = base + 16 * q; Zc[i + (i >> 4)] = o[q]; }
    }
    __syncthreads();
#pragma unroll
    for (int it = 0; it < 2; ++it) { const int jj = tid + 512 * it, c3 = jj >> 8, j3 = jj & 255;
        LAS f32x2* Z3 = Z + c3 * CS; f32x2 a[8], c[8];
#pragma unroll
        for (int r = 0; r < 8; ++r) { const int i = j3 + 256 * r; a[r] = Z3[i + (i >> 4)]; if (r) a[r] = cmul(a[r], tw_rev((float)(r * j3) * (1.0f / 2048.0f))); }
        fft8(a, c);
#pragma unroll
        for (int r = 0; r < 8; ++r) { const int i = j3 + 256 * r; Z3[i + (i >> 4)] = c[r]; } }
    __syncthreads();
    bf16_t* dst = (bf16_t*)(ws + O_CAT) + (size_t)b * SEQ * D + n0;
#pragma unroll
    for (int i = 0; i < 4; ++i) { const int pos = tid + 512 * i, sl = pos + (pos >> 4);
        constexpr float NRM = 0.02209708691207961f;
        u32x2 w; w.x = pk2(Z[sl].x * NRM, Z[CS + sl].x * NRM); w.y = pk2(Z[2 * CS + sl].x * NRM, Z[3 * CS + sl].x * NRM);
        *(u32x2*)(dst + (size_t)pos * D) = w; }
    __syncthreads();
}

__device__ __forceinline__ void phase_mix(const Params& p, LAS unsigned char* lds, LAS int* s_item, int l, int rep) {
    unsigned char* ws = p.ws;
    const bool cx = (l == 0);
    const int nA = 64, nFF = 64, nFC = cx ? 1 : 0, nAC = cx ? 8 : 0, nCV = cx ? 36 : 32;
    const int total = nA + nFF + nFC + nAC + nCV;
    const int xcc = (int)(xb_xcc_id() & 7u);
    unsigned live = 0xffu;
    for (int k = 0; k < 8; ++k) {
        const int x = (xcc + k) & 7;
        unsigned* ctr = (unsigned*)(ws + O_MISC) + 16 + (l * 8 + x) * 8;
        if (k == 1) {
            __syncthreads();
            if (threadIdx.x == 0) {
                const unsigned* cb = (const unsigned*)(ws + O_MISC) + 16 + (l * 8) * 8; unsigned c0, c1, c2, c3, c4, c5, c6, c7;
                asm volatile("global_load_dword %0, %8, off sc1\n\t" "global_load_dword %1, %8, off offset:32 sc1\n\t" "global_load_dword %2, %8, off offset:64 sc1\n\t"
                             "global_load_dword %3, %8, off offset:96 sc1\n\t" "global_load_dword %4, %8, off offset:128 sc1\n\t" "global_load_dword %5, %8, off offset:160 sc1\n\t"
                             "global_load_dword %6, %8, off offset:192 sc1\n\t" "global_load_dword %7, %8, off offset:224 sc1\n\t" "s_waitcnt vmcnt(0)"
                             : "=&v"(c0), "=&v"(c1), "=&v"(c2), "=&v"(c3), "=&v"(c4), "=&v"(c5), "=&v"(c6), "=&v"(c7) : "v"(cb) : "memory");
                const unsigned t = (unsigned)total;
                *s_item = (int)((c0 < t ? 1u : 0u) | (c1 < t ? 2u : 0u) | (c2 < t ? 4u : 0u) | (c3 < t ? 8u : 0u) | (c4 < t ? 16u : 0u) | (c5 < t ? 32u : 0u) | (c6 < t ? 64u : 0u) | (c7 < t ? 128u : 0u));
            }
            __syncthreads();
            live = (unsigned)*s_item;
        }
        if (!((live >> x) & 1u)) continue;
        for (;;) {
            __syncthreads();
            if (threadIdx.x == 0) *s_item = (int)atomicAdd(ctr, 1u);
            __syncthreads();
            int it = *s_item;
            if (it >= total) break;
            if (it < nA) { const int qb = it & 15, bh = (it >> 4) * 8 + x; attn_item(p, lds, l, bh >> 3, bh & 7, qb, false); continue; }
            it -= nA;
            if (it < nFF) { const int id = x * 64 + it; fft_item(p, lds, id >> 7, (id & 127) * 4); continue; }
            it -= nFF;
            if (it < nFC) { const int b = x >> 1, pn = x & 1;
                SchedOne S; S.u.a = (const char*)(ws + O_DFTC); S.u.b = (const char*)(ws + O_ABTC) + ((size_t)pn * 256 * 2048 + b * 512) * 2;
                S.u.nt = 8; S.u.kind = 0; S.u.pm = 0; S.u.pn = pn;
                EpiBf16<0> E; E.O = (bf16_t*)(ws + O_CAT) + (size_t)(NLAT + b * CTXL) * D; E.ldc = D;
                pg8::gemm_phase(lds, 512, 2048, S, E);
                continue; }
            it -= nFC;
            if (it < nAC) { const int qb = it & 1, bh = (it >> 1) * 8 + x; attn_item(p, lds, l, bh >> 3, bh & 7, qb, true); continue; }
            it -= nAC;
            { const int id = x * nCV + it; if (id < 256) conv_item(p, lds, l, id >> 6, id & 63); else { const int j = id - 256; conv_item(p, lds, l, 4 + (j >> 3), j & 7); } }
        }
    }
}

constexpr int NPH = 16;
__global__ void __launch_bounds__(512, 2) mega(Params p) {
    extern __shared__ __attribute__((aligned(16))) unsigned char shm[];
    LAS unsigned char* lds = (LAS unsigned char*)shm;
    unsigned char* ws = p.ws;
    const int G = gridDim.x, c = blockIdx.x;
    const float* MOD = (const float*)(ws + O_MOD);
    volatile LAS unsigned* xst = (volatile LAS unsigned*)(lds + LDS_BYTES + 16);
    if (threadIdx.x == 0) { xst[0] = 0u; xst[1] = 0u; }
    __syncthreads();
    const XcdBarrier xb = xcd_barrier_post((unsigned*)(ws + O_BAR), xst);
    if (p.ph_lo < 0) cg::this_grid().sync();
    for (int ph = p.ph_lo; ph < p.ph_hi; ++ph) {
        if (ph > p.ph_lo) xcd_barrier(xb);
        if (ph == 0) { phase_prep(p, lds); if (PROBE_DUP & 1) { __syncthreads(); phase_prep(p, lds); } continue; }
        if (ph == 1) {
            {
                for (int it = c; it < 64; it += G) { const int l = it >> 5, g = (it >> 3) & 3, pn = it & 7;
                    SchedOne S; S.u.a = (const char*)(ws + O_MTP + l * SZ_MTP) + (size_t)g * 256 * 256 * 2; S.u.b = (const char*)(ws + O_WINF + l * SZ_WINF) + ((size_t)pn * 256 * 640 + g * 128) * 2;
                    S.u.nt = 4; S.u.kind = 0; S.u.pm = g; S.u.pn = pn;
                    EpiBf16<0> E; E.O = (bf16_t*)(ws + O_WINT + l * SZ_WINT); E.ldc = 2048;
                    pg8::gemm_phase(lds, 256, 640, S, E); }
                for (int it = (G >= 96 ? (c >= 64 ? c - 64 : c + G - 64) : c); it < 32; it += G) { const int l = it >> 4, pm = (it >> 1) & 7, pn = it & 1;
                    SchedOne S; S.u.a = (const char*)(ws + O_WTMP + l * SZ_WTMP) + (size_t)pm * 256 * 512 * 2; S.u.b = (const char*)(ws + O_WPW + l * SZ_WPW) + (size_t)pn * 256 * 512 * 2;
                    S.u.nt = 8; S.u.kind = 0; S.u.pm = pm; S.u.pn = pn;
                    EpiBf16<0> E; E.O = (bf16_t*)(ws + O_WOUTF + l * SZ_WOUTF) + 512; E.ldc = 2048;
                    pg8::gemm_phase(lds, 512, 512, S, E); }
            }
            RowArgs a{}; a.mode = 0; a.hasH = true; a.nrows = NROW; a.xlat = p.x; a.xctx = p.ctx; a.gn = p.g_pre_mix; a.modn = MOD; a.sh_off = 0; a.sc_off = 2048; a.H = (bf16_t*)(ws + O_H);
            phase_rows(a); if (PROBE_DUP & 8) { phase_rows(a); phase_rows(a); for (int q = 0; q < 8; ++q) xcd_barrier(xb); } continue;
        }
        const int l = (ph - 2) / 7, sp = (ph - 2) % 7;
        for (int rep = 0; rep < (((PROBE_DUP & 2) && (sp == 0 || sp == 2 || sp == 4 || sp == 5)) ? 2 : 1); ++rep) {
        const bool cx = (l == 0);
        const float* xl = cx ? p.x : p.out; const float* xc = cx ? p.ctx : (const float*)(ws + O_CX);
        if (sp == 0) { SchedP2 S; S.H = (const char*)(ws + O_H); S.W = (const char*)(ws + O_WINT + l * SZ_WINT); S.G = G; S.c = c; EpiP2 E; E.ws = ws; E.layer = l; pg8::gemm_phase(lds, 2048, 2048, S, E); }
        else if (sp == 1) { phase_mix(p, lds, (LAS int*)(lds + LDS_BYTES), l, 0); }
        else if (sp == 2) { SchedGrid S; S.A = (const char*)(ws + O_CAT); S.B = (const char*)(ws + O_WOUTF + l * SZ_WOUTF); S.lda = 2048; S.ldb = 2048; S.nM = 32; S.nN = 8; S.nt = 32; S.nsplit = cx ? 8 : 0; S.G = G; S.c = c;
            EpiY E; E.Y = (bf16_t*)(ws + O_Y); E.YP = (bf16_t*)(ws + O_YP); E.split_stride = (size_t)NCTX * D; pg8::gemm_phase(lds, 2048, 2048, S, E); }
        else if (sp == 3) { RowArgs a{}; a.mode = 1; a.hasH = true; a.nrows = cx ? NROW : NLAT; a.xlat = xl; a.xctx = xc; a.olat = p.out; a.octx = (float*)(ws + O_CX);
            a.Y = (const bf16_t*)(ws + O_Y); a.YP = (const bf16_t*)(ws + O_YP); a.bias = (const float*)(ws + O_BO) + l * 2048; a.gpost = p.g_post_mix + l * D; a.gn = p.g_pre_mlp + l * D;
            a.mod = MOD + (size_t)l * 5 * 12288; a.modn = a.mod; a.gate_off = 4096; a.sh_off = 6144; a.sc_off = 8192; a.H = (bf16_t*)(ws + O_H); a.x16 = (const bf16_t*)(ws + O_X16); a.o16 = (bf16_t*)(ws + O_X16); a.in16 = !cx; a.out16 = true; phase_rows(a); }
        else if (sp == 4) { SchedGrid S; S.A = (const char*)(ws + O_H); S.B = (const char*)(ws + O_WMI + l * SZ_WMI); S.lda = 2048; S.ldb = 2048; S.nM = cx ? 36 : 32; S.nN = 32; S.nt = 32; S.nsplit = 0; S.G = G; S.c = c;
            EpiBf16<1> E; E.O = (bf16_t*)(ws + O_T); E.ldc = DFF; pg8::gemm_phase(lds, 2048, 2048, S, E); }
        else if (sp == 5) { SchedGrid S; S.A = (const char*)(ws + O_T); S.B = (const char*)(ws + O_WMO + l * SZ_WMO); S.lda = 8192; S.ldb = 8192; S.nM = 32; S.nN = 8; S.nt = 128; S.nsplit = cx ? 8 : 0; S.G = G; S.c = c;
            EpiY E; E.Y = (bf16_t*)(ws + O_Y); E.YP = (bf16_t*)(ws + O_YP); E.split_stride = (size_t)NCTX * D; pg8::gemm_phase(lds, 8192, 8192, S, E); }
        else { RowArgs a{}; a.mode = 1; a.hasH = cx; a.nrows = cx ? NROW : NLAT; a.xlat = p.out; a.xctx = (const float*)(ws + O_CX); a.olat = p.out; a.octx = (float*)(ws + O_CX);
            a.Y = (const bf16_t*)(ws + O_Y); a.YP = (const bf16_t*)(ws + O_YP); a.bias = nullptr; a.gpost = p.g_post_mlp + l * D; a.gn = p.g_pre_mix + (l + 1 < 2 ? l + 1 : l) * D;
            a.mod = MOD + (size_t)l * 5 * 12288; a.modn = MOD + (size_t)(l + 1 < 2 ? l + 1 : l) * 5 * 12288; a.gate_off = 10240; a.sh_off = 0; a.sc_off = 2048; a.H = (bf16_t*)(ws + O_H); a.x16 = (const bf16_t*)(ws + O_X16); a.o16 = (bf16_t*)(ws + O_X16); a.in16 = true; a.out16 = cx; phase_rows(a); }
        }
    }
}

extern "C" void kernel_launch(void* const* d_in, const int* in_sizes, int n_in, void* d_out, int out_size, void* d_ws, size_t ws_size, hipStream_t stream) {
    static int grid = 0;
    if (grid == 0) {
        if (n_in != 26 || ws_size < WS_END) { fprintf(stderr, "kernel_launch: unexpected n_in %d or workspace %zu < %zu\n", n_in, ws_size, (size_t)WS_END); }
        int dev = 0, cus = 0, per_cu = 0;
        (void)hipGetDevice(&dev); (void)hipDeviceGetAttribute(&cus, hipDeviceAttributeMultiprocessorCount, dev);
        (void)hipFuncSetAttribute((const void*)mega, hipFuncAttributeMaxDynamicSharedMemorySize, LDS_TOTAL);
        (void)hipOccupancyMaxActiveBlocksPerMultiprocessor(&per_cu, (const void*)mega, NTHR, LDS_TOTAL);
        if (per_cu < 1) { fprintf(stderr, "kernel_launch: occupancy query says %d blocks/CU\n", per_cu); per_cu = 1; }
        (void)hipGetLastError();
        grid = cus * 1;
    }
    (void)hipMemsetAsync((unsigned char*)d_ws + O_BAR, 0, 16384, stream);
    Params p{};
    const float** f = (const float**)&p;
    for (int i = 0; i < 26; ++i) f[i] = (const float*)d_in[i];
    p.out = (float*)d_out; p.ws = (unsigned char*)d_ws;
#if MK_MULTI
    for (int ph = 0; ph < NPH; ++ph) { p.ph_lo = ph; p.ph_hi = ph + 1; hipLaunchKernelGGL(mega, dim3(grid), dim3(NTHR), LDS_TOTAL, stream, p); }
#else
    p.ph_lo = 0; p.ph_hi = NPH;
    void* args[] = {&p};
    hipError_t e = hipLaunchCooperativeKernel((const void*)mega, dim3(grid), dim3(NTHR), args, LDS_TOTAL, stream);
    if (e != hipSuccess) fprintf(stderr, "cooperative launch failed: %s (grid %d)\n", hipGetErrorString(e), grid);
#endif
}
```

```cpp
#include <hip/hip_runtime.h>
#include <hip/hip_cooperative_groups.h>
#include <cstdio>
namespace cg = cooperative_groups;

#ifndef MK_MULTI
#define MK_MULTI 0
#endif

#ifndef PROBE_DUP
#define PROBE_DUP 0
#endif
#define LAS __attribute__((address_space(3)))
typedef unsigned short bf16_t;
typedef short bf16x8 __attribute__((ext_vector_type(8)));
typedef float f32x4 __attribute__((ext_vector_type(4)));
typedef float f32x16 __attribute__((ext_vector_type(16)));
typedef unsigned u32x4 __attribute__((ext_vector_type(4)));
typedef unsigned u32x2 __attribute__((ext_vector_type(2)));

constexpr int D = 2048, NB = 4, SEQ = 2048, CTXL = 256, NLAT = NB * SEQ, NCTX = NB * CTXL, NROW = NLAT + NCTX;
constexpr int DFF = 8192, LK = CTXL + SEQ, INC = 4608, NH = 8;
constexpr float EPS = 1e-6f;
constexpr float QSCALE = 0.125f * 1.4426950408889634f;
constexpr int NTHR = 512;
constexpr int LDS_BYTES = 131072;
constexpr int LDS_TOTAL = LDS_BYTES + 64;

constexpr size_t al256(size_t x) { return (x + 255) & ~(size_t)255; }
constexpr size_t SZ_WINT = (size_t)5120 * 2048 * 2, SZ_WINF = (size_t)2048 * 640 * 2, SZ_MTP = (size_t)1024 * 256 * 2, SZ_WOUTF = (size_t)2048 * 2048 * 2,
                 SZ_WTMP = (size_t)2048 * 512 * 2, SZ_WPW = (size_t)512 * 512 * 2, SZ_WMI = (size_t)8192 * 2048 * 2, SZ_WMO = SZ_WMI;
constexpr size_t O_WINT = 0;
constexpr size_t O_WINF = O_WINT + 2 * SZ_WINT;
constexpr size_t O_MTP = O_WINF + 2 * SZ_WINF;
constexpr size_t O_WOUTF = O_MTP + 2 * SZ_MTP;
constexpr size_t O_WTMP = O_WOUTF + 2 * SZ_WOUTF;
constexpr size_t O_WPW = O_WTMP + 2 * SZ_WTMP;
constexpr size_t O_WMI = O_WPW + 2 * SZ_WPW;
constexpr size_t O_WMO = O_WMI + 2 * SZ_WMI;
constexpr size_t O_DFT = O_WMO + 2 * SZ_WMO;
constexpr size_t O_DFTC = O_DFT + (size_t)2048 * 4096 * 2;
constexpr size_t O_MOD = O_DFTC + (size_t)256 * 512 * 2;
constexpr size_t O_BO = O_MOD + al256((size_t)2 * 5 * 12288 * 4);
constexpr size_t O_ROPE = O_BO + (size_t)2 * 2048 * 4;
constexpr size_t O_MISC = O_ROPE + (size_t)2048 * 64 * 4;
constexpr size_t O_KMAX = O_MISC + 1024;
constexpr size_t O_CX = O_MISC + 2048;
constexpr size_t O_H = O_CX + (size_t)NCTX * D * 4;
constexpr size_t O_ABT = O_H + (size_t)NROW * D * 2;
constexpr size_t O_ABTC = O_ABT + (size_t)512 * 16384 * 2;
constexpr size_t O_Z = O_ABTC + (size_t)512 * 2048 * 2;
constexpr size_t O_Q = O_Z + (size_t)NROW * 512 * 2;
constexpr size_t O_KK = O_Q + (size_t)NROW * 1024 * 2;
constexpr size_t O_VT = O_KK + (size_t)NB * NH * 2 * LK * 64 * 2;
constexpr size_t O_CAT = O_VT + (size_t)NB * NH * 128 * LK * 2;
constexpr size_t O_Y = O_CAT + (size_t)NROW * D * 2;
constexpr size_t O_YP = O_Y + (size_t)NROW * D * 4;
constexpr size_t O_T = O_YP + (size_t)8 * NCTX * D * 4;
constexpr size_t O_BAR = O_T + (size_t)NROW * DFF * 2;
constexpr size_t O_X16 = O_BAR + 16384;
constexpr size_t WS_END = O_X16 + (size_t)NROW * D * 2;

struct Params {
    const float *x, *c, *ctx, *c_ctx, *w_ada, *b_ada, *g_pre_mix, *g_post_mix, *g_pre_mlp, *g_post_mlp, *w_in, *w_out, *w_fourier, *w_dw, *b_dw,
        *g_conv_ln, *b_conv_ln, *w_conv_pw, *b_conv_pw, *lq1, *lk1, *lq2, *lk2, *g_subln, *w_mlp_in, *w_mlp_out;
    float* out; unsigned char* ws; int ph_lo, ph_hi;
};

__device__ __forceinline__ unsigned pk2(float lo, float hi) { unsigned r; asm volatile("v_cvt_pk_bf16_f32 %0, %1, %2" : "=v"(r) : "v"(lo), "v"(hi)); return r; }
__device__ __forceinline__ float bf_lo(unsigned v) { return __uint_as_float(v << 16); }
__device__ __forceinline__ float bf_hi(unsigned v) { return __uint_as_float(v & 0xffff0000u); }
__device__ __forceinline__ float wave_sum(float v) {
#pragma unroll
    for (int o = 1; o < 64; o <<= 1) v += __shfl_xor(v, o);
    return v;
}
__device__ __forceinline__ int opaque_tid() { int t = threadIdx.x; asm volatile("" : "+v"(t)); return t; }
__device__ __forceinline__ float fsigmoid(float x) { return __builtin_amdgcn_rcpf(1.0f + __expf(-x)); }
__device__ __forceinline__ float cos_rev(float r) { return __builtin_amdgcn_cosf(r); }
__device__ __forceinline__ float sin_rev(float r) { return __builtin_amdgcn_sinf(r); }


#define XB_TMO      128
#define XB_XCNT(j)  (256  + 64 * (j))
#define XB_XSUB(j)  (1280 + 64 * (j))
#define XB_XGEN(j)  (2304 + 64 * (j))
#define XB_TOP      3328
#define XB_TOPGEN   3392
#define XCD_BAR_WORDS 3456
#define XB_SPIN_CAP (1u << 22)
__device__ __forceinline__ unsigned xb_ld(unsigned* p)              { return __hip_atomic_load(p, __ATOMIC_RELAXED, __HIP_MEMORY_SCOPE_AGENT); }
__device__ __forceinline__ unsigned xb_add(unsigned* p, unsigned v) { return __hip_atomic_fetch_add(p, v, __ATOMIC_RELAXED, __HIP_MEMORY_SCOPE_AGENT); }
__device__ __forceinline__ unsigned xb_xcc_id() { return (unsigned)__builtin_amdgcn_s_getreg((3 << 11) | 20) & 0xFu; }
#define XB_SPIN(cond, bar) do { unsigned _sp = 0; while (cond) { __builtin_amdgcn_s_sleep(1); \
    if ((++_sp & 255u) == 0u) { if (xb_ld(&(bar)[XB_TMO])) break; if (_sp > XB_SPIN_CAP) { atomicAdd(&(bar)[XB_TMO], 1u); break; } } } } while (0)
struct XcdBarrier { unsigned* bar; unsigned x; volatile LAS unsigned* st; };
__device__ __forceinline__ XcdBarrier xcd_barrier_post(unsigned* bar, volatile LAS unsigned* st) {
    XcdBarrier b; b.bar = bar; b.x = xb_xcc_id(); b.st = st;
    if (threadIdx.x == 0) (void)xb_add(&bar[XB_XCNT(b.x)], 1u);
    return b;
}
__device__ __forceinline__ void xcd_barrier_complete(unsigned* bar, unsigned x, unsigned& nloc, unsigned& nx) {
    const unsigned G = gridDim.x * gridDim.y * gridDim.z;
    unsigned sum, cnt, mine, sp = 0u;
    for (;;) {
        sum = 0u; cnt = 0u; mine = 0u;
        unsigned cc[16];
        {
            const unsigned* cb = &bar[XB_XCNT(0)];
            asm volatile(
                "global_load_dword %0, %16, off sc1\n\t"            "global_load_dword %1, %16, off offset:256 sc1\n\t"
                "global_load_dword %2, %16, off offset:512 sc1\n\t" "global_load_dword %3, %16, off offset:768 sc1\n\t"
                "global_load_dword %4, %16, off offset:1024 sc1\n\t" "global_load_dword %5, %16, off offset:1280 sc1\n\t"
                "global_load_dword %6, %16, off offset:1536 sc1\n\t" "global_load_dword %7, %16, off offset:1792 sc1\n\t"
                "global_load_dword %8, %16, off offset:2048 sc1\n\t" "global_load_dword %9, %16, off offset:2304 sc1\n\t"
                "global_load_dword %10, %16, off offset:2560 sc1\n\t" "global_load_dword %11, %16, off offset:2816 sc1\n\t"
                "global_load_dword %12, %16, off offset:3072 sc1\n\t" "global_load_dword %13, %16, off offset:3328 sc1\n\t"
                "global_load_dword %14, %16, off offset:3584 sc1\n\t" "global_load_dword %15, %16, off offset:3840 sc1\n\t"
                "s_waitcnt vmcnt(0)"
                : "=&v"(cc[0]), "=&v"(cc[1]), "=&v"(cc[2]), "=&v"(cc[3]), "=&v"(cc[4]), "=&v"(cc[5]), "=&v"(cc[6]), "=&v"(cc[7]),
                  "=&v"(cc[8]), "=&v"(cc[9]), "=&v"(cc[10]), "=&v"(cc[11]), "=&v"(cc[12]), "=&v"(cc[13]), "=&v"(cc[14]), "=&v"(cc[15])
                : "v"(cb) : "memory");
        }
#pragma unroll
        for (unsigned j = 0; j < 16; ++j) { const unsigned c = cc[j]; sum += c; cnt += (c > 0u) ? 1u : 0u; mine = (j == x) ? c : mine; }
        if (sum == G) break;
        __builtin_amdgcn_s_sleep(1);
        if ((++sp & 255u) == 0u) { if (xb_ld(&bar[XB_TMO])) break; if (sp > XB_SPIN_CAP) { atomicAdd(&bar[XB_TMO], 1u); break; } }
    }
    nloc = mine > 0u ? mine : 1u; nx = cnt > 0u ? cnt : 1u;
}
__device__ __forceinline__ void xcd_barrier(const XcdBarrier& b) {
    asm volatile("s_waitcnt vmcnt(0)" ::: "memory");
    __syncthreads();
    if (threadIdx.x == 0) {
        unsigned* bar = b.bar;
        __builtin_amdgcn_s_waitcnt(0);
        unsigned nloc = b.st[0], nx = b.st[1];
        if (nloc == 0u) { xcd_barrier_complete(bar, b.x, nloc, nx); b.st[0] = nloc; b.st[1] = nx; }
        const unsigned old = xb_add(&bar[XB_XSUB(b.x)], 1u);
        const unsigned gen = old / nloc;
        if (old + 1u == (gen + 1u) * nloc) {
            __builtin_amdgcn_fence(__ATOMIC_RELEASE, "agent");
            asm volatile("s_waitcnt vmcnt(0)" ::: "memory");
            const unsigned og = xb_add(&bar[XB_TOP], 1u);
            const unsigned tg = og / nx;
            if (og + 1u == (tg + 1u) * nx) xb_add(&bar[XB_TOPGEN], 1u);
            else XB_SPIN(xb_ld(&bar[XB_TOPGEN]) == tg, bar);
            __builtin_amdgcn_fence(__ATOMIC_ACQUIRE, "agent");
            xb_add(&bar[XB_XGEN(b.x)], 1u);
            asm volatile("s_waitcnt vmcnt(0)" ::: "memory");
        } else {
            XB_SPIN(xb_ld(&bar[XB_XGEN(b.x)]) == gen, bar);
            __builtin_amdgcn_fence(__ATOMIC_ACQUIRE, "agent");
            asm volatile("s_waitcnt vmcnt(0)" ::: "memory");
        }
    }
    __syncthreads();
}

namespace pg8 {
constexpr int BM = 256, BK = 64, HALF = 128, HTB = HALF * BK * 2;
__device__ __forceinline__ int lds_byte(int r, int c) { const int st = (r >> 4) * 2 + (c >> 5), rr = r & 15, cc = c & 31, ob = rr * 64 + cc * 2; return st * 1024 + (ob ^ (((ob >> 9) & 1) << 5)); }
__device__ __forceinline__ void stage_rc(int b, int& R, int& C) { const int st = b / 1024, sb = b % 1024, swz = sb ^ (((sb >> 9) & 1) << 5); R = (st >> 1) * 16 + swz / 64; C = (st & 1) * 32 + (swz % 64) / 2; }
__device__ __forceinline__ int perm32(int rho) { const int n = rho >> 4, i = rho & 15; return 8 * (i >> 2) + 4 * n + (i & 3); }

struct Unit { const char* a; const char* b; int nt, kind, pm, pn; };

template <class Epi, class Sched>
__device__ __forceinline__ void gemm_phase(LAS unsigned char* lds, const int lda, const int ldb, const Sched& S, const Epi& E) {
    const int tid = opaque_tid(), wid = __builtin_amdgcn_readfirstlane(tid >> 6), lane = tid & 63, wr = wid >> 2, wc = wid & 3, fr = lane & 15, fq = lane >> 4;
    unsigned voffA[2], voffB[2];
#pragma unroll
    for (int i = 0; i < 2; ++i) { int R, C; stage_rc(tid * 16 + i * 8192, R, C); const int Rb = Epi::PERM ? ((R & ~31) + perm32(R & 31)) : R;
        voffA[i] = (unsigned)(R * lda + C) * 2u; voffB[i] = (unsigned)(Rb * ldb + C) * 2u; }
    const size_t kstep = (size_t)(BK * 2);
    const size_t hstepA = (size_t)HALF * lda * 2, hstepB = (size_t)HALF * ldb * 2;
    const unsigned ldsw = (unsigned)wid * 1024u;
    const int aoff = lds_byte(wr * 64 + fr, fq * 8), boff = lds_byte(wc * 32 + fr, fq * 8);
#define PG8_SA(b, h) (((b) * 2 + (h)) * HTB)
#define PG8_SB(b, h) ((4 + (b) * 2 + (h)) * HTB)
#define PG8_STAGE(bufoff, gbase, voff) do { _Pragma("unroll") for (int _i = 0; _i < 2; ++_i) \
        __builtin_amdgcn_global_load_lds((const unsigned*)((const char*)(gbase) + (voff)[_i]), (LAS unsigned*)(lds + (bufoff) + ldsw + _i * 8192), 16, 0, 0); } while (0)
#define PG8_LDA(dst, b, h) do { _Pragma("unroll") for (int m = 0; m < 4; ++m) _Pragma("unroll") for (int k = 0; k < 2; ++k) dst[m][k] = *(const LAS bf16x8*)(lds + PG8_SA(b, h) + aoff + m * 2048 + k * 1024); } while (0)
#define PG8_LDB(dst, b, h) do { _Pragma("unroll") for (int n = 0; n < 2; ++n) _Pragma("unroll") for (int k = 0; k < 2; ++k) dst[n][k] = *(const LAS bf16x8*)(lds + PG8_SB(b, h) + boff + n * 2048 + k * 1024); } while (0)
#define PG8_MMA(ai, bj, At, Bt) do { __builtin_amdgcn_s_setprio(1); _Pragma("unroll") for (int m = 0; m < 4; ++m) _Pragma("unroll") for (int n = 0; n < 2; ++n) _Pragma("unroll") for (int k = 0; k < 2; ++k) \
        acc[ai][bj][m][n] = __builtin_amdgcn_mfma_f32_16x16x32_bf16(Bt[n][k], At[m][k], acc[ai][bj][m][n], 0, 0, 0); __builtin_amdgcn_s_setprio(0); } while (0)
#define PG8_WAIT_V(n) asm volatile("s_waitcnt vmcnt(" #n ")" ::: "memory")
#define PG8_WAIT_L(n) asm volatile("s_waitcnt lgkmcnt(" #n ")" ::: "memory")
#define PG8_BAR __builtin_amdgcn_s_barrier()
#define PG8_SCHED __builtin_amdgcn_sched_barrier(0)
    Unit cur, nxt; int ui = 0;
    if (!S.next(0, cur)) return;
    f32x4 acc[2][2][4][2];
#pragma unroll
    for (int a = 0; a < 2; ++a)
#pragma unroll
        for (int b = 0; b < 2; ++b)
#pragma unroll
            for (int m = 0; m < 4; ++m)
#pragma unroll
                for (int n = 0; n < 2; ++n) acc[a][b][m][n] = (f32x4){0.f, 0.f, 0.f, 0.f};
    bf16x8 At[4][2], B0[2][2], B1[2][2];
    const char* cA = cur.a; const char* cB = cur.b;
    PG8_STAGE(PG8_SB(0, 0), cB, voffB); PG8_STAGE(PG8_SA(0, 0), cA, voffA); PG8_STAGE(PG8_SB(0, 1), cB + hstepB, voffB); PG8_STAGE(PG8_SA(0, 1), cA + hstepA, voffA);
    PG8_STAGE(PG8_SB(1, 0), cB + kstep, voffB); PG8_STAGE(PG8_SA(1, 0), cA + kstep, voffA); PG8_STAGE(PG8_SB(1, 1), cB + hstepB + kstep, voffB);
    if (wr == 1) PG8_BAR;
    PG8_WAIT_V(10); PG8_BAR;
    PG8_WAIT_V(6); PG8_BAR;
    for (;;) {
        const bool has_next = S.next(ui + 1, nxt);
        const char* nA = has_next ? nxt.a : cA; const char* nB = has_next ? nxt.b : cB;
        const int nt = cur.nt;
        for (int t = 0; t < nt; t += 2) {
            const bool last = (t == nt - 2);
            const char* a1 = cA + (size_t)(t + 1) * kstep;
            const char* a2 = last ? nA : cA + (size_t)(t + 2) * kstep; const char* b2 = last ? nB : cB + (size_t)(t + 2) * kstep;
            const char* a3 = a2 + kstep; const char* b3 = b2 + kstep;
            PG8_LDB(B0, 0, 0); PG8_SCHED; PG8_LDA(At, 0, 0); PG8_STAGE(PG8_SA(1, 1), a1 + hstepA, voffA);
            PG8_WAIT_L(8); PG8_BAR; PG8_WAIT_L(0); PG8_MMA(0, 0, At, B0); PG8_BAR; PG8_SCHED;
            PG8_LDB(B1, 0, 1); PG8_STAGE(PG8_SB(0, 0), b2, voffB);
            PG8_BAR; PG8_WAIT_L(0); PG8_MMA(0, 1, At, B1); PG8_BAR;
            PG8_LDA(At, 0, 1); PG8_STAGE(PG8_SA(0, 0), a2, voffA);
            PG8_BAR; PG8_WAIT_L(0); PG8_MMA(1, 0, At, B0); PG8_BAR; PG8_SCHED;
            PG8_STAGE(PG8_SB(0, 1), b2 + hstepB, voffB);
            PG8_WAIT_V(6); PG8_BAR; PG8_MMA(1, 1, At, B1); PG8_BAR;
            PG8_LDB(B0, 1, 0); PG8_SCHED; PG8_LDA(At, 1, 0); PG8_STAGE(PG8_SA(0, 1), a2 + hstepA, voffA);
            PG8_WAIT_L(8); PG8_BAR; PG8_WAIT_L(0); PG8_MMA(0, 0, At, B0); PG8_BAR; PG8_SCHED;
            PG8_LDB(B1, 1, 1); PG8_STAGE(PG8_SB(1, 0), b3, voffB);
            PG8_BAR; PG8_WAIT_L(0); PG8_MMA(0, 1, At, B1); PG8_BAR;
            PG8_LDA(At, 1, 1); PG8_STAGE(PG8_SA(1, 0), a3, voffA);
            PG8_BAR; PG8_WAIT_L(0); PG8_MMA(1, 0, At, B0); PG8_BAR; PG8_SCHED;
            PG8_STAGE(PG8_SB(1, 1), b3 + hstepB, voffB);
            PG8_WAIT_V(6); PG8_BAR; PG8_MMA(1, 1, At, B1); PG8_BAR;
        }
        { int lane2; asm volatile("v_mov_b32 %0, %1" : "=v"(lane2) : "v"(lane));
          E(acc, cur, wr, wc, lane2 & 15, lane2 >> 4); }
        if (!has_next) break;
#pragma unroll
        for (int a = 0; a < 2; ++a)
#pragma unroll
            for (int b = 0; b < 2; ++b)
#pragma unroll
                for (int m = 0; m < 4; ++m)
#pragma unroll
                    for (int n = 0; n < 2; ++n) acc[a][b][m][n] = (f32x4){0.f, 0.f, 0.f, 0.f};
        cur = nxt; cA = nA; cB = nB; ++ui;
    }
    PG8_WAIT_V(0);
    if (wr == 0) PG8_BAR;
    PG8_BAR;
#undef PG8_SA
#undef PG8_SB
#undef PG8_STAGE
#undef PG8_LDA
#undef PG8_LDB
#undef PG8_MMA
#undef PG8_WAIT_V
#undef PG8_WAIT_L
#undef PG8_BAR
#undef PG8_SCHED
}
__device__ __forceinline__ int xcd_remap(int wgid, int nwg) { const int q = nwg / 8, r = nwg % 8, xcd = wgid % 8, off = wgid / 8; return (xcd < r ? xcd * (q + 1) : r * (q + 1) + (xcd - r) * q) + off; }
__device__ __forceinline__ void grid_decode(int w, int nM, int nN, int& pm, int& pn) { const int nig = 8 * nN, gid = w / nig, fm = gid * 8, gsz = (nM - fm) < 8 ? (nM - fm) : 8; pm = fm + ((w % nig) % gsz); pn = (w % nig) / gsz; }
}
using pg8::Unit;

enum { K_TFOLD = 0, K_TV = 1, K_NGLU = 2, K_NQ = 3, K_NK = 4 };
struct SchedP2 {
    const char* H; const char* W; int G, c;
    __device__ __forceinline__ bool next(int i, Unit& u) const {
        const int L = i * G + c; if (L >= 720) return false;
        int w = pg8::xcd_remap(L, 720); int pm, pn;
        { const int x = w / 90, j = w - 90 * x; w = j < 36 ? 36 * x + j : 288 + 54 * x + (j - 36); }
        if (w < 288) { pg8::grid_decode(w, 8, 36, pm, pn); u.kind = pm < 4 ? K_TFOLD : K_TV; u.a = W + (size_t)pm * 256 * 4096; u.b = H + (size_t)pn * 256 * 4096; }
        else { w -= 288; pg8::grid_decode(w, 36, 12, pm, pn); u.kind = K_NGLU + (pn >> 2); u.a = H + (size_t)pm * 256 * 4096; u.b = W + (size_t)(2048 + pn * 256) * 4096; }
        u.pm = pm; u.pn = pn; u.nt = 32; return true;
    }
};
struct SchedGrid {
    const char* A; const char* B; int lda, ldb, nM, nN, nt, nsplit  , G, c;
    __device__ __forceinline__ bool next(int i, Unit& u) const {
        const int nmain = nM * nN, ntot = nmain + 4 * nN * nsplit;
        const int L = i * G + c; if (L >= ntot) return false;
        if (L < nmain) { const int w = pg8::xcd_remap(L, nmain); int pm, pn; pg8::grid_decode(w, nM, nN, pm, pn);
            u.kind = 0; u.pm = pm; u.pn = pn; u.nt = nt; u.a = A + (size_t)pm * 256 * lda * 2; u.b = B + (size_t)pn * 256 * ldb * 2; }
        else { const int idx = L - nmain, s = idx & 7, rest = idx >> 3, pn = rest % nN, pm = 32 + rest / nN; const int snt = nt >> 3;
            u.kind = 1 + s; u.pm = pm; u.pn = pn; u.nt = snt; u.a = A + (size_t)pm * 256 * lda * 2 + (size_t)s * snt * 128; u.b = B + (size_t)pn * 256 * ldb * 2 + (size_t)s * snt * 128; }
        return true;
    }
};
struct SchedOne { Unit u; __device__ __forceinline__ bool next(int i, Unit& o) const { if (i) return false; o = u; return true; } };

struct EpiP2 {
    static constexpr bool PERM = true;
    unsigned char* ws; int layer;
    __device__ __forceinline__ void operator()(const f32x4 (&acc)[2][2][4][2], const Unit& u, int wr, int wc, int fr, int fq) const {
        if (u.kind == K_TFOLD || u.kind == K_TV) {
#pragma unroll
            for (int ai = 0; ai < 2; ++ai)
#pragma unroll
                for (int m = 0; m < 4; ++m) {
                    const int rr = 128 * ai + 64 * wr + 16 * m + fr;
#pragma unroll
                    for (int bj = 0; bj < 2; ++bj) {
                        const int tok = 256 * u.pn + 128 * bj + 32 * wc + 8 * fq;
                        const f32x4 v0 = acc[ai][bj][m][0], v1 = acc[ai][bj][m][1];
                        u32x4 w; w.x = pk2(v0[0], v0[1]); w.y = pk2(v0[2], v0[3]); w.z = pk2(v1[0], v1[1]); w.w = pk2(v1[2], v1[3]);
                        const bool lat = tok < NLAT; const int t2 = tok - NLAT;
                        const int b = lat ? (tok >> 11) : (t2 >> 8), pos = lat ? (tok & 2047) : (t2 & 255);
                        bf16_t* dst;
                        if (u.kind == K_TFOLD) { const int g = u.pm, cs = rr >> 7, e = rr & 127;
                            dst = lat ? (bf16_t*)(ws + O_ABT) + (size_t)(g * 128 + e) * 16384 + b * 4096 + cs * 2048 + pos
                                      : (bf16_t*)(ws + O_ABTC) + (size_t)(g * 128 + e) * 2048 + b * 512 + cs * 256 + pos; }
                        else { const int n2 = 256 * (u.pm - 4) + rr, h = n2 >> 7, e = n2 & 127;
                            dst = (bf16_t*)(ws + O_VT) + ((size_t)(b * NH + h) * 128 + e) * LK + (lat ? 256 + pos : pos); }
                        *(u32x4*)dst = w;
                    }
                }
        } else {
            const float* rope = (const float*)(ws + O_ROPE);
            float kmx0 = 0.f, kmx1 = 0.f;
            const int pnl = u.pn & 3;
            if (u.kind == K_NGLU) {
#pragma unroll
                for (int ai = 0; ai < 2; ++ai)
#pragma unroll
                    for (int m = 0; m < 4; ++m) {
                        const int tok = 256 * u.pm + 128 * ai + 64 * wr + 16 * m + fr;
#pragma unroll
                        for (int bj = 0; bj < 2; ++bj) {
                            const f32x4 v0 = acc[ai][bj][m][0], v1 = acc[ai][bj][m][1];
                            const int cl = 256 * pnl + 128 * bj + 32 * wc + 8 * fq;
                            u32x2 w; w.x = pk2(v0[0] * fsigmoid(v1[0]), v0[1] * fsigmoid(v1[1])); w.y = pk2(v0[2] * fsigmoid(v1[2]), v0[3] * fsigmoid(v1[3]));
                            *(u32x2*)((bf16_t*)(ws + O_Z) + (size_t)tok * 512 + (cl >> 1)) = w;
                        }
                    }
            } else {
                const int d1 = ((wc & 1) * 4 + fq) * 4;
                f32x4 rc[2][4], rs[2][4];
#pragma unroll
                for (int ai = 0; ai < 2; ++ai)
#pragma unroll
                    for (int m = 0; m < 4; ++m) { const int tok = 256 * u.pm + 128 * ai + 64 * wr + 16 * m + fr;
                        const float* rp = rope + (size_t)(tok < NLAT ? (tok & 2047) : 0) * 64 + d1;
                        rc[ai][m] = *(const f32x4*)rp; rs[ai][m] = *(const f32x4*)(rp + 32); }
#pragma unroll
                for (int ai = 0; ai < 2; ++ai)
#pragma unroll
                    for (int m = 0; m < 4; ++m) {
                        const int tok = 256 * u.pm + 128 * ai + 64 * wr + 16 * m + fr;
                        const bool lat = tok < NLAT; const int t2 = tok - NLAT;
                        const int b = lat ? (tok >> 11) : (t2 >> 8), pos = lat ? (tok & 2047) : (t2 & 255);
                        const f32x4 cs = lat ? rc[ai][m] : (f32x4){1.f, 1.f, 1.f, 1.f}, sn = lat ? rs[ai][m] : (f32x4){0.f, 0.f, 0.f, 0.f};
#pragma unroll
                        for (int bj = 0; bj < 2; ++bj) {
                            const f32x4 v0 = acc[ai][bj][m][0], v1 = acc[ai][bj][m][1];
                            const int blk = 4 * pnl + 2 * bj + (wc >> 1);
                            f32x4 o1 = v0 * cs - v1 * sn, o2 = v1 * cs + v0 * sn;
                            if (u.kind == K_NQ) { o1 = o1 * QSCALE; o2 = o2 * QSCALE;
                                bf16_t* dst = (bf16_t*)(ws + O_Q) + (size_t)tok * 1024 + blk * 64 + d1;
                                u32x2 w1, w2; w1.x = pk2(o1[0], o1[1]); w1.y = pk2(o1[2], o1[3]); w2.x = pk2(o2[0], o2[1]); w2.y = pk2(o2[2], o2[3]);
                                *(u32x2*)dst = w1; *(u32x2*)(dst + 32) = w2;
                            } else {
                                const int key = lat ? 256 + pos : pos;
                                { float ps = (o1[0] * o1[0] + o1[1] * o1[1]) + (o1[2] * o1[2] + o1[3] * o1[3]) + (o2[0] * o2[0] + o2[1] * o2[1]) + (o2[2] * o2[2] + o2[3] * o2[3]);
                                  ps += __shfl_xor(ps, 16); ps += __shfl_xor(ps, 32);
                                  if (bj == 0) kmx0 = fmaxf(kmx0, ps); else kmx1 = fmaxf(kmx1, ps); }
                                bf16_t* dst = (bf16_t*)(ws + O_KK) + ((size_t)(b * 16 + blk) * LK + key) * 64 + d1;
                                u32x2 w1, w2; w1.x = pk2(o1[0], o1[1]); w1.y = pk2(o1[2], o1[3]); w2.x = pk2(o2[0], o2[1]); w2.y = pk2(o2[2], o2[3]);
                                *(u32x2*)dst = w1; *(u32x2*)(dst + 32) = w2;
                            }
                        }
                    }
            }
            if (u.kind == K_NK) {
#pragma unroll
                for (int o = 1; o < 16; o <<= 1) { kmx0 = fmaxf(kmx0, __shfl_xor(kmx0, o)); kmx1 = fmaxf(kmx1, __shfl_xor(kmx1, o)); }
                const int tok0 = 256 * u.pm; const int b = tok0 < NLAT ? (tok0 >> 11) : ((tok0 - NLAT) >> 8);
                const int blk0 = 4 * (u.pn & 3) + (wc >> 1);
                if (fr == 0 && fq == 0) { unsigned* km = (unsigned*)(ws + O_KMAX) + layer * 64 + b * 16 + blk0;
                    atomicMax(km, __float_as_uint(2.0f * kmx0)); atomicMax(km + 2, __float_as_uint(2.0f * kmx1)); }
            }
        }
    }
};
struct EpiY {
    static constexpr bool PERM = true;
    bf16_t* Y; bf16_t* YP; size_t split_stride;
    __device__ __forceinline__ void operator()(const f32x4 (&acc)[2][2][4][2], const Unit& u, int wr, int wc, int fr, int fq) const {
        const int row0 = wr * 64 + fr, col0 = u.pn * 256 + wc * 32 + 8 * fq;
        bf16_t* base = u.kind == 0 ? Y + (size_t)u.pm * 256 * D : YP + (size_t)(u.kind - 1) * split_stride + (size_t)(u.pm - 32) * 256 * D;
#pragma unroll
        for (int ai = 0; ai < 2; ++ai)
#pragma unroll
            for (int m = 0; m < 4; ++m) { bf16_t* rowp = base + (size_t)(row0 + ai * 128 + m * 16) * D + col0;
#pragma unroll
                for (int bj = 0; bj < 2; ++bj) { const f32x4 v0 = acc[ai][bj][m][0], v1 = acc[ai][bj][m][1];
                    u32x4 w; w.x = pk2(v0[0], v0[1]); w.y = pk2(v0[2], v0[3]); w.z = pk2(v1[0], v1[1]); w.w = pk2(v1[2], v1[3]);
                    *(u32x4*)(rowp + bj * 128) = w; } }
    }
};

template <int ACT  > struct EpiBf16 {
    static constexpr bool PERM = true;
    bf16_t* O; int ldc;
    __device__ __forceinline__ void operator()(const f32x4 (&acc)[2][2][4][2], const Unit& u, int wr, int wc, int fr, int fq) const {
        const int row0 = u.pm * 256 + wr * 64 + fr, col0 = u.pn * 256 + wc * 32 + 8 * fq;
#pragma unroll
        for (int ai = 0; ai < 2; ++ai)
#pragma unroll
            for (int m = 0; m < 4; ++m) { bf16_t* rowp = O + (size_t)(row0 + ai * 128 + m * 16) * ldc + col0;
#pragma unroll
                for (int bj = 0; bj < 2; ++bj) { f32x4 v0 = acc[ai][bj][m][0], v1 = acc[ai][bj][m][1];
                    if (ACT == 1) {
#pragma unroll
                        for (int j = 0; j < 4; ++j) { const float a = fmaxf(v0[j], 0.f), b = fmaxf(v1[j], 0.f); v0[j] = a * a; v1[j] = b * b; } }
                    u32x4 w; w.x = pk2(v0[0], v0[1]); w.y = pk2(v0[2], v0[3]); w.z = pk2(v1[0], v1[1]); w.w = pk2(v1[2], v1[3]);
                    *(u32x4*)(rowp + bj * 128) = w; } }
    }
};

template <class RowMap>
__device__ __forceinline__ void tr_tile(const float* src, int ldn, int k0, int n0, bf16_t* dst, int ldk, int kdst0, const RowMap& rm, LAS float* scr) {
    const int tid = opaque_tid();
    f32x4 v[8];
#pragma unroll
    for (int i = 0; i < 8; ++i) { const int idx = tid + 512 * i, kk = idx >> 4, c = (idx & 15) * 4; v[i] = *(const f32x4*)(src + (size_t)(k0 + kk) * ldn + n0 + c); }
#pragma unroll
    for (int i = 0; i < 8; ++i) { const int idx = tid + 512 * i, kk = idx >> 4, c = (idx & 15) * 4;
        scr[kk * 65 + c] = v[i][0]; scr[kk * 65 + c + 1] = v[i][1]; scr[kk * 65 + c + 2] = v[i][2]; scr[kk * 65 + c + 3] = v[i][3]; }
    __syncthreads();
    { const int n = tid >> 3, kc = tid & 7; bf16_t* drow = dst + (size_t)rm(n0 + n) * ldk + kdst0 + kc * 8;
        float tv[4][8];
#pragma unroll
        for (int hf = 0; hf < 4; ++hf) { const LAS float* s = scr + (hf * 64 + kc * 8) * 65 + n;
#pragma unroll
            for (int j = 0; j < 8; ++j) tv[hf][j] = s[j * 65]; }
#pragma unroll
        for (int hf = 0; hf < 4; ++hf) {
            u32x4 o; o.x = pk2(tv[hf][0], tv[hf][1]); o.y = pk2(tv[hf][2], tv[hf][3]); o.z = pk2(tv[hf][4], tv[hf][5]); o.w = pk2(tv[hf][6], tv[hf][7]);
            *(u32x4*)(drow + hf * 64) = o; } }
    __syncthreads();
}
struct RmId { __device__ __forceinline__ int operator()(int n) const { return n; } };
struct RmWin {
    __device__ __forceinline__ int operator()(int n) const {
        if (n < 1536) { const int x = n - 512, ch = x & 511, gate = x >> 9; return 2048 + (ch >> 2) * 8 + gate * 4 + (ch & 3); }
        if (n < 3584) { const int x = n - 1536, blk = x >> 6, d = x & 63; return 3072 + blk * 64 + ((d & 31) >> 2) * 8 + (d >> 5) * 4 + (d & 3); }
        return 1024 + (n - 3584);
    }
};

__device__ __forceinline__ void phase_prep(const Params& p, LAS unsigned char* lds) {
    const int tid = opaque_tid(), G = gridDim.x;
    unsigned char* ws = p.ws;
    LAS float* scr = (LAS float*)lds;
    constexpr int I_ADA = 768, I_TRL = 512 + 256 + 1024 + 1024, I_TR = 2 * I_TRL;
    constexpr int I_WINF = 640, I_WPW = 128, I_DFT = 0, I_DFTC = 32, I_ROPE = 16, I_MT = 128, I_BO = 32, I_MISC = 1;
    constexpr int NIT = I_ADA + I_TR + I_WINF + I_WPW + I_DFT + I_DFTC + I_ROPE + I_MT + I_BO + I_MISC;
    bool sc_ready = false;
    for (int it = blockIdx.x; it < NIT; it += G) {
        int r = it < I_MT + I_BO + I_MISC ? NIT - (I_MT + I_BO + I_MISC) + it : it - (I_MT + I_BO + I_MISC);
        if (r < I_ADA) {
            const int l = r / 384, n0 = (r % 384) * 32;
            LAS float* sc = scr;
            if (!sc_ready) { for (int i = tid; i < 5 * 2048; i += NTHR) { const int bi = i >> 11, k = i & 2047; const float v = bi < 4 ? p.c[bi * 2048 + k] : p.c_ctx[k]; sc[i] = v * fsigmoid(v); } sc_ready = true; }
            __syncthreads();
            const int kg = tid >> 3, c4 = (tid & 7) * 4;
            f32x4 a[5];
#pragma unroll
            for (int bi = 0; bi < 5; ++bi) a[bi] = (f32x4){0.f, 0.f, 0.f, 0.f};
            const float* W = p.w_ada + (size_t)l * 2048 * 12288 + n0 + c4;
#pragma unroll 1
            for (int i0 = 0; i0 < 32; i0 += 8) {
                f32x4 w[8];
#pragma unroll
                for (int u = 0; u < 8; ++u) w[u] = *(const f32x4*)(W + (size_t)(kg + 64 * (i0 + u)) * 12288);
#pragma unroll
                for (int u = 0; u < 8; ++u) { const int k = kg + 64 * (i0 + u);
#pragma unroll
                    for (int bi = 0; bi < 5; ++bi) a[bi] += w[u] * sc[bi * 2048 + k]; } }
            LAS float* red = scr + 5 * 2048;
#pragma unroll
            for (int bi = 0; bi < 5; ++bi)
#pragma unroll
                for (int j = 0; j < 4; ++j) red[(kg * 8 + (tid & 7)) * 20 + bi * 4 + j] = a[bi][j];
            __syncthreads();
            if (tid < 160) { const int cl = tid / 20, q = tid % 20; float s = 0.f; for (int g = 0; g < 64; ++g) s += red[(g * 8 + cl) * 20 + q];
                const int bi = q >> 2, j = q & 3, n = n0 + cl * 4 + j;
                ((float*)(ws + O_MOD))[(size_t)(l * 5 + bi) * 12288 + n] = s + p.b_ada[l * 12288 + n]; }
            __syncthreads();
            continue;
        }
        r -= I_ADA; sc_ready = false;
        if (r < I_TR) {
            const int l = r / I_TRL; int q = r % I_TRL;
            if (l == 1 && q >= 768) continue;
            if (q < 512) { const int kt = q >> 6, ntile = q & 63; tr_tile(p.w_in + (size_t)l * 2048 * INC, INC, kt * 256, 512 + ntile * 64, (bf16_t*)(ws + O_WINT + l * SZ_WINT), 2048, kt * 256, RmWin(), scr); continue; }
            q -= 512;
            if (q < 256) { const int kt = q >> 5, ntile = q & 31; const int k0 = kt * 256;
                if (k0 >= 512 && k0 < 1024) tr_tile(p.w_out + (size_t)l * 2048 * 2048, 2048, k0, ntile * 64, (bf16_t*)(ws + O_WTMP + l * SZ_WTMP), 512, k0 - 512, RmId(), scr);
                else tr_tile(p.w_out + (size_t)l * 2048 * 2048, 2048, k0, ntile * 64, (bf16_t*)(ws + O_WOUTF + l * SZ_WOUTF), 2048, k0, RmId(), scr);
                continue; }
            q -= 256;
            if (q < 1024) { const int kt = q >> 7, ntile = q & 127; tr_tile(p.w_mlp_in + (size_t)l * 2048 * 8192, 8192, kt * 256, ntile * 64, (bf16_t*)(ws + O_WMI + l * SZ_WMI), 2048, kt * 256, RmId(), scr); continue; }
            q -= 1024;
            { const int kt = q >> 5, ntile = q & 31; tr_tile(p.w_mlp_out + (size_t)l * 8192 * 2048, 2048, kt * 256, ntile * 64, (bf16_t*)(ws + O_WMO + l * SZ_WMO), 8192, kt * 256, RmId(), scr); continue; }
        }
        r -= I_TR;
        if (r < I_WINF) {
            const size_t e0 = (size_t)r * 4096 + (size_t)tid * 8; const int l = (int)(e0 / (2048 * 640)); const size_t x = e0 % (2048 * 640); const int k = (int)(x / 640), c = (int)(x % 640);
            u32x4 o = (u32x4){0u, 0u, 0u, 0u};
            if (c < 512) { const float* s = p.w_in + ((size_t)l * 2048 + k) * INC + c; const f32x4 a = *(const f32x4*)s, b = *(const f32x4*)(s + 4);
                o.x = pk2(a[0], a[1]); o.y = pk2(a[2], a[3]); o.z = pk2(b[0], b[1]); o.w = pk2(b[2], b[3]); }
            *(u32x4*)((bf16_t*)(ws + O_WINF) + e0) = o; continue;
        }
        r -= I_WINF;
        if (r < I_WPW) { const size_t e0 = (size_t)r * 4096 + (size_t)tid * 8; const float* s = p.w_conv_pw + e0; const f32x4 a = *(const f32x4*)s, b = *(const f32x4*)(s + 4);
            u32x4 o; o.x = pk2(a[0], a[1]); o.y = pk2(a[2], a[3]); o.z = pk2(b[0], b[1]); o.w = pk2(b[2], b[3]); *(u32x4*)((bf16_t*)(ws + O_WPW) + e0) = o; continue; }
        r -= I_WPW;
        if (r < I_DFT) {
            const size_t e0 = (size_t)r * 4096 + (size_t)tid * 8; const int j = (int)(e0 >> 12), k0 = (int)(e0 & 4095);
            float v[8];
#pragma unroll
            for (int i = 0; i < 8; ++i) { const int k = k0 + i, kk = k & 2047; const float rev = (float)((j * kk) & 2047) * (1.0f / 2048.0f);
                v[i] = (k < 2048 ? cos_rev(rev) : -sin_rev(rev)) * 0.02209708691207961f; }
            u32x4 o; o.x = pk2(v[0], v[1]); o.y = pk2(v[2], v[3]); o.z = pk2(v[4], v[5]); o.w = pk2(v[6], v[7]); *(u32x4*)((bf16_t*)(ws + O_DFT) + e0) = o; continue;
        }
        r -= I_DFT;
        if (r < I_DFTC) {
            const size_t e0 = (size_t)r * 4096 + (size_t)tid * 8; const int j = (int)(e0 >> 9), k0 = (int)(e0 & 511);
            float v[8];
#pragma unroll
            for (int i = 0; i < 8; ++i) { const int k = k0 + i, kk = k & 255; const float rev = (float)((j * kk) & 255) * (1.0f / 256.0f);
                v[i] = (k < 256 ? cos_rev(rev) : -sin_rev(rev)) * 0.0625f; }
            u32x4 o; o.x = pk2(v[0], v[1]); o.y = pk2(v[2], v[3]); o.z = pk2(v[4], v[5]); o.w = pk2(v[6], v[7]); *(u32x4*)((bf16_t*)(ws + O_DFTC) + e0) = o; continue;
        }
        r -= I_DFTC;
        if (r < I_ROPE) {
#pragma unroll
            for (int i = 0; i < 8; ++i) { const int e = r * 4096 + i * 512 + tid, pos = e >> 5, f = e & 31;
                const float inv = exp2f(-(float)(f & 15) * (13.287712379549449f / 16.0f));
                const float ang = (float)(f < 16 ? (pos >> 6) : (pos & 63)) * inv;
                float rev = ang * 0.15915494309189535f; rev -= floorf(rev);
                float* o = (float*)(ws + O_ROPE) + (size_t)pos * 64 + f; o[0] = cos_rev(rev); o[32] = sin_rev(rev); }
            continue;
        }
        r -= I_ROPE;
        if (r < I_MT) {
            const int l = r >> 6, g = (r >> 4) & 3, cs = (r >> 3) & 1, cq = r & 7;
            const float* Wf = p.w_fourier + (size_t)(l * 4 + g) * 128 * 128;
            LAS float* sw = scr;
            LAS float* tb = scr + 128 * 128;
            for (int i = tid; i < 128 * 128; i += NTHR) sw[i] = Wf[i];
            if (tid < 128) { const float rev = (float)tid * (1.0f / 128.0f); tb[tid] = (cs ? sin_rev(rev) : cos_rev(rev)) * 0.08838834764831845f; }
            __syncthreads();
            bf16_t* dst = (bf16_t*)(ws + O_MTP + l * SZ_MTP) + (size_t)(g * 256 + cs * 128) * 256;
            for (int o = tid; o < 16 * 128; o += NTHR) { const int e = o & 127, c = cq * 16 + (o >> 7); float s = 0.f;
#pragma unroll 8
                for (int c2 = 0; c2 < 128; ++c2) s += tb[(c * c2) & 127] * sw[c2 * 128 + e];
                dst[(size_t)e * 256 + c] = (bf16_t)(pk2(s, 0.f) & 0xffffu); dst[(size_t)e * 256 + 128 + c] = 0; }
            __syncthreads();
            continue;
        }
        r -= I_MT;
        if (r < I_BO) {
            const int l = r >> 4, n = (r & 15) * 128 + (tid & 127), jq = tid >> 7;
            const float* W = p.w_out + ((size_t)l * 2048 + 512 + jq * 128) * 2048 + n; const float* bp = p.b_conv_pw + l * 512 + jq * 128;
            float s = 0.f;
#pragma unroll 1
            for (int j0 = 0; j0 < 128; j0 += 16) { float w[16];
#pragma unroll
                for (int u = 0; u < 16; ++u) w[u] = W[(size_t)(j0 + u) * 2048];
#pragma unroll
                for (int u = 0; u < 16; ++u) s += bp[j0 + u] * w[u]; }
            scr[tid] = s;
            __syncthreads();
            if (tid < 128) ((float*)(ws + O_BO))[l * 2048 + n] = (scr[tid] + scr[tid + 128]) + (scr[tid + 256] + scr[tid + 384]);
            __syncthreads();
            continue;
        }
        r -= I_BO;
        {
            if (tid < 128) { const int l = tid >> 6, i = tid & 63; const float a = wave_sum(p.lq1[l * 64 + i] * p.lk1[l * 64 + i]), b = wave_sum(p.lq2[l * 64 + i] * p.lk2[l * 64 + i]);
                if (i == 0) ((float*)(ws + O_MISC))[l] = __expf(a) - __expf(b) + (0.8f - 0.6f * __expf(-0.3f * (float)l)); }
            if (tid >= 128 && tid < 144) ((unsigned*)(ws + O_MISC))[16 + (tid - 128) * 8] = 0u;
            if (tid >= 256 && tid < 384) ((unsigned*)(ws + O_KMAX))[tid - 256] = 0u;
        }
    }
}

struct RowArgs {
    int mode; bool hasH; int nrows;
    const float* xlat; const float* xctx; float* olat; float* octx;
    const bf16_t* Y; const bf16_t* YP; const float* bias;
    const float* gpost; const float* gn; const float* mod;
    const float* modn; int gate_off, sh_off, sc_off; bf16_t* H;
    const bf16_t* x16; bf16_t* o16; bool in16, out16;
};
__device__ __forceinline__ void phase_rows(const RowArgs& a) {
    const int tid = opaque_tid(), lane = tid & 63, wid = tid >> 6, gw = blockIdx.x * 8 + wid, NW = gridDim.x * 8;
    for (int r = gw; r < a.nrows; r += NW) {
        const bool lat = r < NLAT; const int bi = lat ? (r >> 11) : 4;
        int l4 = lane * 4; asm volatile("" : "+v"(l4));
        const float* xr = (lat ? a.xlat + (size_t)r * D : a.xctx + (size_t)(r - NLAT) * D) + l4;
        f32x4 x[8];
        if (a.in16) { u32x2 w[8];
#pragma unroll
            for (int j = 0; j < 8; ++j) w[j] = *(const u32x2*)(a.x16 + (size_t)r * D + l4 + 256 * j);
#pragma unroll
            for (int j = 0; j < 8; ++j) x[j] = (f32x4){bf_lo(w[j].x), bf_hi(w[j].x), bf_lo(w[j].y), bf_hi(w[j].y)};
        } else {
#pragma unroll
            for (int j = 0; j < 8; ++j) x[j] = *(const f32x4*)(xr + 256 * j);
        }
        if (a.mode == 1) {
            f32x4 y[8];
            if (lat) {
                u32x2 w[8];
#pragma unroll
                for (int j = 0; j < 8; ++j) w[j] = *(const u32x2*)(a.Y + (size_t)r * D + l4 + 256 * j);
#pragma unroll
                for (int j = 0; j < 8; ++j) y[j] = (f32x4){bf_lo(w[j].x), bf_hi(w[j].x), bf_lo(w[j].y), bf_hi(w[j].y)};
            } else {
#pragma unroll
                for (int j = 0; j < 8; ++j) y[j] = (f32x4){0.f, 0.f, 0.f, 0.f};
#pragma unroll 1
                for (int q = 0; q < 8; q += 4) { const bf16_t* yp = a.YP + (size_t)q * NCTX * D + (size_t)(r - NLAT) * D + l4;
                    u32x2 t[4][8];
#pragma unroll
                    for (int qq = 0; qq < 4; ++qq)
#pragma unroll
                        for (int j = 0; j < 8; ++j) t[qq][j] = *(const u32x2*)(yp + (size_t)qq * NCTX * D + 256 * j);
#pragma unroll
                    for (int qq = 0; qq < 4; ++qq)
#pragma unroll
                        for (int j = 0; j < 8; ++j) y[j] += (f32x4){bf_lo(t[qq][j].x), bf_hi(t[qq][j].x), bf_lo(t[qq][j].y), bf_hi(t[qq][j].y)}; }
            }
            if (a.bias) {
                f32x4 bv[8];
#pragma unroll
                for (int j = 0; j < 8; ++j) bv[j] = *(const f32x4*)(a.bias + l4 + 256 * j);
#pragma unroll
                for (int j = 0; j < 8; ++j) y[j] += bv[j]; }
            const float* gate = a.mod + (size_t)bi * 12288 + a.gate_off + l4;
            f32x4 g[8], gp[8];
#pragma unroll
            for (int j = 0; j < 8; ++j) { g[j] = *(const f32x4*)(gate + 256 * j); gp[j] = *(const f32x4*)(a.gpost + l4 + 256 * j); }
            float ss = 0.f;
#pragma unroll
            for (int j = 0; j < 8; ++j) ss += (y[j][0] * y[j][0] + y[j][1] * y[j][1]) + (y[j][2] * y[j][2] + y[j][3] * y[j][3]);
            const float rstd = rsqrtf(wave_sum(ss) * (1.0f / D) + EPS);
#pragma unroll
            for (int j = 0; j < 8; ++j) x[j] = x[j] + g[j] * (y[j] * rstd * gp[j]);
        }
        if (a.hasH) {
            const float* sh = a.modn + (size_t)bi * 12288 + a.sh_off + l4; const float* sc = a.modn + (size_t)bi * 12288 + a.sc_off + l4;
            f32x4 gn[8], s1[8], s2[8];
#pragma unroll
            for (int j = 0; j < 8; ++j) { gn[j] = *(const f32x4*)(a.gn + l4 + 256 * j); s1[j] = *(const f32x4*)(sh + 256 * j); s2[j] = *(const f32x4*)(sc + 256 * j); }
            float ss = 0.f;
#pragma unroll
            for (int j = 0; j < 8; ++j) ss += (x[j][0] * x[j][0] + x[j][1] * x[j][1]) + (x[j][2] * x[j][2] + x[j][3] * x[j][3]);
            const float rstd = rsqrtf(wave_sum(ss) * (1.0f / D) + EPS);
            u32x2 w[8];
#pragma unroll
            for (int j = 0; j < 8; ++j) { const f32x4 h = (x[j] * rstd * gn[j]) * (s2[j] + 1.0f) + s1[j]; w[j].x = pk2(h[0], h[1]); w[j].y = pk2(h[2], h[3]); }
#pragma unroll
            for (int j = 0; j < 8; ++j) *(u32x2*)(a.H + (size_t)r * D + l4 + 256 * j) = w[j];
        }
        if (a.mode == 1) {
            if (a.out16) {
#pragma unroll
                for (int j = 0; j < 8; ++j) { u32x2 w; w.x = pk2(x[j][0], x[j][1]); w.y = pk2(x[j][2], x[j][3]); *(u32x2*)(a.o16 + (size_t)r * D + l4 + 256 * j) = w; }
            } else {
                float* orow = (lat ? a.olat + (size_t)r * D : a.octx + (size_t)(r - NLAT) * D) + l4;
#pragma unroll
                for (int j = 0; j < 8; ++j) *(f32x4*)(orow + 256 * j) = x[j];
            }
        }
    }
}

__device__ __forceinline__ void attn_item(const Params& p, LAS unsigned char* lds, int l, int b, int h, int qb, bool isctx) {
    unsigned char* ws = p.ws;
    const int tid = opaque_tid(), wid = __builtin_amdgcn_readfirstlane(tid >> 6), lane = tid & 63, mm = wid >> 2, rg = wid & 3, qi = lane & 31, hh = lane >> 5;
    const int nt = isctx ? 4 : 36;
    const int qrow = (isctx ? NLAT + b * 256 : b * 2048) + qb * 128 + rg * 32 + qi;
    bf16x8 Bq[4];
    { const bf16_t* Q = (const bf16_t*)(ws + O_Q) + (size_t)qrow * 1024 + h * 128 + mm * 64 + hh * 8;
#pragma unroll
        for (int ks = 0; ks < 4; ++ks) Bq[ks] = *(const bf16x8*)(Q + ks * 16); }
    const char* Kb = (const char*)(ws + O_KK) + (size_t)((b * NH + h) * 2) * LK * 128;
    const char* Vb = (const char*)(ws + O_VT) + (size_t)(b * NH + h) * 128 * LK * 2;
    const int skey = tid >> 3, sch = tid & 7;
    const unsigned koff = (unsigned)(skey * 128 + sch * 16);
    const char* Kb1 = Kb + (size_t)LK * 128;
    const int kdst = skey * 128 + ((sch ^ ((skey >> 1) & 7)) * 16);
    const int e0s = skey, e1s = skey + 64;
    const unsigned voff = (unsigned)(e0s * (LK * 2) + sch * 16); const char* Vb1 = Vb + (size_t)64 * (LK * 2);
    const int vsw = (skey >> 1) & 7;
    const int vdA = (((sch & 6)) ^ vsw) * 16 + (sch & 1) * 8, vdB = (((sch & 6) + 1) ^ vsw) * 16 + (sch & 1) * 8;
    const int vdst0 = e0s * 128, vdst1 = e1s * 128;
    u32x4 rk0, rk1, rv0, rv1;
#define ATT_LOAD(t) do { rk0 = *(const u32x4*)(Kb + (koff + (unsigned)(t) * 8192u)); rk1 = *(const u32x4*)(Kb1 + (koff + (unsigned)(t) * 8192u)); \
        rv0 = *(const u32x4*)(Vb + (voff + (unsigned)(t) * 128u)); rv1 = *(const u32x4*)(Vb1 + (voff + (unsigned)(t) * 128u)); } while (0)
#define ATT_STORE(buf) do { *(LAS u32x4*)(lds + (buf) * 16384 + kdst) = rk0; *(LAS u32x4*)(lds + (buf) * 16384 + 8192 + kdst) = rk1; \
        *(LAS u32x2*)(lds + 32768 + (buf) * 16384 + vdst0 + vdA) = (u32x2){rv0.x, rv0.y}; *(LAS u32x2*)(lds + 32768 + (buf) * 16384 + vdst0 + vdB) = (u32x2){rv0.z, rv0.w}; \
        *(LAS u32x2*)(lds + 32768 + (buf) * 16384 + vdst1 + vdA) = (u32x2){rv1.x, rv1.y}; *(LAS u32x2*)(lds + 32768 + (buf) * 16384 + vdst1 + vdB) = (u32x2){rv1.z, rv1.w}; } while (0)
    f32x16 oacc[4];
#pragma unroll
    for (int et = 0; et < 4; ++et)
#pragma unroll
        for (int r = 0; r < 16; ++r) oacc[et][r] = 0.f;
    float lsum = 0.f, nmref;
    { float qs = 0.f;
#pragma unroll
        for (int ks = 0; ks < 4; ++ks) { const u32x4 w = __builtin_bit_cast(u32x4, Bq[ks]);
#pragma unroll
            for (int j = 0; j < 4; ++j) { const float a = bf_lo(w[j]), c = bf_hi(w[j]); qs += a * a + c * c; } }
        qs += __shfl_xor(qs, 32);
        const float k2 = __uint_as_float(((const unsigned*)(ws + O_KMAX))[l * 64 + b * 16 + h * 2 + mm]);
        nmref = -(sqrtf(qs * k2) * 1.02f + 1e-6f); }
    const int ksw = (qi >> 1) & 7;
    const int kread = mm * 8192 + qi * 128;
    const int vread = 32768 + qi * 128;
    ATT_LOAD(0);
    const u32x4 rk2 = *(const u32x4*)(Kb + (koff + 8192u)), rk3 = *(const u32x4*)(Kb1 + (koff + 8192u));
    { *(LAS u32x4*)(lds + kdst) = rk0; *(LAS u32x4*)(lds + 8192 + kdst) = rk1;
      *(LAS u32x2*)(lds + 32768 + 16384 + vdst0 + vdA) = (u32x2){rv0.x, rv0.y}; *(LAS u32x2*)(lds + 32768 + 16384 + vdst0 + vdB) = (u32x2){rv0.z, rv0.w};
      *(LAS u32x2*)(lds + 32768 + 16384 + vdst1 + vdA) = (u32x2){rv1.x, rv1.y}; *(LAS u32x2*)(lds + 32768 + 16384 + vdst1 + vdB) = (u32x2){rv1.z, rv1.w}; }
    { *(LAS u32x4*)(lds + 16384 + kdst) = rk2; *(LAS u32x4*)(lds + 16384 + 8192 + kdst) = rk3; }
    __syncthreads();
    f32x16 s0, s1;
#pragma unroll
    for (int r = 0; r < 16; ++r) { s0[r] = nmref; s1[r] = nmref; }
#pragma unroll
    for (int ks = 0; ks < 4; ++ks) {
        const int co = ((2 * ks + hh) ^ ksw) * 16;
        const bf16x8 a0 = *(const LAS bf16x8*)(lds + kread + co);
        const bf16x8 a1 = *(const LAS bf16x8*)(lds + kread + 4096 + co);
        s0 = __builtin_amdgcn_mfma_f32_32x32x16_bf16(a0, Bq[ks], s0, 0, 0, 0);
        s1 = __builtin_amdgcn_mfma_f32_32x32x16_bf16(a1, Bq[ks], s1, 0, 0, 0);
    }
    bf16x8 Pf[4];
#pragma unroll
    for (int i = 0; i < 4; ++i) Pf[i] = (bf16x8){0, 0, 0, 0, 0, 0, 0, 0};
    for (int t = 0; t < nt; ++t) {
        const int bk = ((t + 1) & 1) * 16384, bv = ((t + 1) & 1) * 16384;
        rv0 = *(const u32x4*)(Vb + (voff + (unsigned)t * 128u)); rv1 = *(const u32x4*)(Vb1 + (voff + (unsigned)t * 128u));
        if (t + 2 < nt) { rk0 = *(const u32x4*)(Kb + (koff + (unsigned)(t + 2) * 8192u)); rk1 = *(const u32x4*)(Kb1 + (koff + (unsigned)(t + 2) * 8192u)); }
#pragma unroll
        for (int s4 = 0; s4 < 4; ++s4) {
            const int c0 = ((2 * s4 + hh) ^ ksw) * 16;
#pragma unroll
            for (int et = 0; et < 4; ++et) {
                const bf16x8 vv = *(const LAS bf16x8*)(lds + bv + vread + et * 4096 + c0);
                oacc[et] = __builtin_amdgcn_mfma_f32_32x32x16_bf16(vv, Pf[s4], oacc[et], 0, 0, 0);
            }
        }
        f32x16 n0, n1;
#pragma unroll
        for (int r = 0; r < 16; ++r) { n0[r] = nmref; n1[r] = nmref; }
#pragma unroll
        for (int ks = 0; ks < 4; ++ks) {
            const int co = ((2 * ks + hh) ^ ksw) * 16;
            const bf16x8 a0 = *(const LAS bf16x8*)(lds + bk + kread + co);
            const bf16x8 a1 = *(const LAS bf16x8*)(lds + bk + kread + 4096 + co);
            n0 = __builtin_amdgcn_mfma_f32_32x32x16_bf16(a0, Bq[ks], n0, 0, 0, 0);
            n1 = __builtin_amdgcn_mfma_f32_32x32x16_bf16(a1, Bq[ks], n1, 0, 0, 0);
        }
        float ps = 0.f;
#pragma unroll
        for (int r = 0; r < 16; ++r) { s0[r] = __builtin_amdgcn_exp2f(s0[r]); s1[r] = __builtin_amdgcn_exp2f(s1[r]); ps += s0[r] + s1[r]; }
        lsum += ps;
        bf16x8 Pn[4];
#pragma unroll
        for (int s = 0; s < 2; ++s) {
            u32x4 w0, w1;
            w0.x = pk2(s0[8 * s + 0], s0[8 * s + 1]); w0.y = pk2(s0[8 * s + 2], s0[8 * s + 3]); w0.z = pk2(s0[8 * s + 4], s0[8 * s + 5]); w0.w = pk2(s0[8 * s + 6], s0[8 * s + 7]);
            w1.x = pk2(s1[8 * s + 0], s1[8 * s + 1]); w1.y = pk2(s1[8 * s + 2], s1[8 * s + 3]); w1.z = pk2(s1[8 * s + 4], s1[8 * s + 5]); w1.w = pk2(s1[8 * s + 6], s1[8 * s + 7]);
            Pn[s] = __builtin_bit_cast(bf16x8, w0); Pn[2 + s] = __builtin_bit_cast(bf16x8, w1);
        }
#pragma unroll
        for (int i = 0; i < 4; ++i) Pf[i] = Pn[i];
        s0 = n0; s1 = n1;
#pragma unroll
        for (int i = 0; i < 24; ++i) { __builtin_amdgcn_sched_group_barrier(0x008, 1, 0); __builtin_amdgcn_sched_group_barrier(0x002, 7, 0); }
        { const int bo = (t & 1) * 16384;
          *(LAS u32x2*)(lds + 32768 + bo + vdst0 + vdA) = (u32x2){rv0.x, rv0.y}; *(LAS u32x2*)(lds + 32768 + bo + vdst0 + vdB) = (u32x2){rv0.z, rv0.w};
          *(LAS u32x2*)(lds + 32768 + bo + vdst1 + vdA) = (u32x2){rv1.x, rv1.y}; *(LAS u32x2*)(lds + 32768 + bo + vdst1 + vdB) = (u32x2){rv1.z, rv1.w};
          if (t + 2 < nt) { *(LAS u32x4*)(lds + bo + kdst) = rk0; *(LAS u32x4*)(lds + bo + 8192 + kdst) = rk1; } }
        __syncthreads();
    }
    {
        const int bv = ((nt - 1) & 1) * 16384;
#pragma unroll
        for (int s4 = 0; s4 < 4; ++s4) {
            const int c0 = ((2 * s4 + hh) ^ ksw) * 16;
#pragma unroll
            for (int et = 0; et < 4; ++et) {
                const bf16x8 vv = *(const LAS bf16x8*)(lds + bv + vread + et * 4096 + c0);
                oacc[et] = __builtin_amdgcn_mfma_f32_32x32x16_bf16(vv, Pf[s4], oacc[et], 0, 0, 0);
            }
        }
    }
#undef ATT_LOAD
#undef ATT_STORE
    const float ltot = lsum + __shfl_xor(lsum, 32), inv = 1.0f / ltot;
    LAS float* comb = (LAS float*)(lds + 65536);
    if (mm == 1) {
#pragma unroll
        for (int et = 0; et < 4; ++et)
#pragma unroll
            for (int r = 0; r < 16; ++r) comb[(rg * 64 + et * 16 + r) * 64 + lane] = oacc[et][r] * inv;
    }
    __syncthreads();
    if (mm == 0) {
        const float lam = ((const float*)(ws + O_MISC))[l];
        const float post = 1.0f - (0.8f - 0.6f * __expf(-0.3f * (float)l));
        float ss = 0.f;
        float cv[4][16];
#pragma unroll
        for (int et = 0; et < 4; ++et)
#pragma unroll
            for (int r = 0; r < 16; ++r) cv[et][r] = comb[(rg * 64 + et * 16 + r) * 64 + lane];
#pragma unroll
        for (int et = 0; et < 4; ++et)
#pragma unroll
            for (int r = 0; r < 16; ++r) { const float o = oacc[et][r] * inv - lam * cv[et][r]; oacc[et][r] = o; ss += o * o; }
        ss += __shfl_xor(ss, 32);
        const float rstd = rsqrtf(ss * (1.0f / 128.0f) + EPS) * post;
        const float* gs = p.g_subln + l * 128;
        bf16_t* dst = (bf16_t*)(ws + O_CAT) + (size_t)qrow * D + 1024 + h * 128;
        f32x4 g[4][4];
#pragma unroll
        for (int et = 0; et < 4; ++et)
#pragma unroll
            for (int rq = 0; rq < 4; ++rq) g[et][rq] = *(const f32x4*)(gs + 32 * et + 8 * rq + 4 * hh);
        u32x2 w[4][4];
#pragma unroll
        for (int et = 0; et < 4; ++et)
#pragma unroll
            for (int rq = 0; rq < 4; ++rq) { w[et][rq].x = pk2(oacc[et][4 * rq] * rstd * g[et][rq][0], oacc[et][4 * rq + 1] * rstd * g[et][rq][1]);
                w[et][rq].y = pk2(oacc[et][4 * rq + 2] * rstd * g[et][rq][2], oacc[et][4 * rq + 3] * rstd * g[et][rq][3]); }
#pragma unroll
        for (int et = 0; et < 4; ++et)
#pragma unroll
            for (int rq = 0; rq < 4; ++rq) *(u32x2*)(dst + 32 * et + 8 * rq + 4 * hh) = w[et][rq];
    }
    __syncthreads();
}

__device__ __forceinline__ void conv_item(const Params& p, LAS unsigned char* lds, int l, int seq, int tile) {
    unsigned char* ws = p.ws;
    const int tid = opaque_tid(), wid = tid >> 6, lane = tid & 63;
    const bool lat = seq < 4; const int L = lat ? SEQ : CTXL; const int row0 = lat ? seq * SEQ : NLAT + (seq - 4) * CTXL; const int pos0 = tile * 32;
    LAS unsigned* zs = (LAS unsigned*)lds;
    LAS float* co = (LAS float*)(lds + 63488);
    const unsigned* Z = (const unsigned*)(ws + O_Z);
    for (int i = tid; i < 62 * 64; i += NTHR) { const int rr = i >> 6, c4 = (i & 63) * 4; const int pos = pos0 - 15 + rr;
        u32x4 v = (u32x4){0u, 0u, 0u, 0u};
        if (pos >= 0 && pos < L) v = *(const u32x4*)(Z + (size_t)(row0 + pos) * 256 + c4);
        *(LAS u32x4*)(zs + rr * 256 + c4) = v; }
    const int cp = tid & 255, th = tid >> 8;
    float w0[31], w1[31];
    const float* wd = p.w_dw + (size_t)l * 31 * 512 + 2 * cp;
#pragma unroll
    for (int j = 0; j < 31; ++j) { w0[j] = wd[j * 512]; w1[j] = wd[j * 512 + 1]; }
    const float b0 = p.b_dw[l * 512 + 2 * cp], b1 = p.b_dw[l * 512 + 2 * cp + 1];
    __syncthreads();
    for (int i = 0; i < 16; ++i) { const int tt = th * 16 + i; float a0 = b0, a1 = b1;
#pragma unroll
        for (int j = 0; j < 31; ++j) { const unsigned v = zs[(tt + j) * 256 + cp]; a0 += w0[j] * bf_lo(v); a1 += w1[j] * bf_hi(v); }
        co[tt * 512 + 2 * cp] = a0; co[tt * 512 + 2 * cp + 1] = a1; }
    __syncthreads();
    const float* gl = p.g_conv_ln + l * 512 + lane * 8; const float* bl = p.b_conv_ln + l * 512 + lane * 8;
    for (int q = 0; q < 4; ++q) { const int tt = wid * 4 + q;
        float v[8]; float s = 0.f;
#pragma unroll
        for (int j = 0; j < 8; ++j) { v[j] = co[tt * 512 + lane * 8 + j]; s += v[j]; }
        const float mean = wave_sum(s) * (1.0f / 512.0f); float s2 = 0.f;
#pragma unroll
        for (int j = 0; j < 8; ++j) { v[j] -= mean; s2 += v[j] * v[j]; }
        const float rstd = rsqrtf(wave_sum(s2) * (1.0f / 512.0f) + EPS);
#pragma unroll
        for (int j = 0; j < 8; ++j) { const float y = v[j] * rstd * gl[j] + bl[j]; v[j] = y * fsigmoid(y); }
        u32x4 o; o.x = pk2(v[0], v[1]); o.y = pk2(v[2], v[3]); o.z = pk2(v[4], v[5]); o.w = pk2(v[6], v[7]);
        *(u32x4*)((bf16_t*)(ws + O_CAT) + (size_t)(row0 + pos0 + tt) * D + 512 + lane * 8) = o; }
    __syncthreads();
}


typedef float f32x2 __attribute__((ext_vector_type(2)));
__device__ __forceinline__ f32x2 cmul(f32x2 a, f32x2 w) { return (f32x2){a.x * w.x - a.y * w.y, a.x * w.y + a.y * w.x}; }
__device__ __forceinline__ f32x2 tw_rev(float f) { return (f32x2){cos_rev(f), -sin_rev(f)}; }
__device__ __forceinline__ void fft4(f32x2& a0, f32x2& a1, f32x2& a2, f32x2& a3) {
    const f32x2 t0 = a0 + a2, t1 = a0 - a2, t2 = a1 + a3, d = a1 - a3; const f32x2 t3 = (f32x2){d.y, -d.x};
    a0 = t0 + t2; a1 = t1 + t3; a2 = t0 - t2; a3 = t1 - t3;
}
__device__ __forceinline__ void fft16(f32x2 (&v)[16], f32x2 (&o)[16]) {
    constexpr float C1 = 0.9238795325112867f, S1 = 0.3826834323650898f, C2 = 0.7071067811865476f;
#pragma unroll
    for (int n1 = 0; n1 < 4; ++n1) fft4(v[n1], v[n1 + 4], v[n1 + 8], v[n1 + 12]);
    v[5] = cmul(v[5], (f32x2){C1, -S1}); v[9] = cmul(v[9], (f32x2){C2, -C2}); v[13] = cmul(v[13], (f32x2){S1, -C1});
    v[6] = cmul(v[6], (f32x2){C2, -C2}); v[10] = (f32x2){v[10].y, -v[10].x}; v[14] = cmul(v[14], (f32x2){-C2, -C2});
    v[7] = cmul(v[7], (f32x2){S1, -C1}); v[11] = cmul(v[11], (f32x2){-C2, -C2}); v[15] = cmul(v[15], (f32x2){-C1, S1});
#pragma unroll
    for (int p = 0; p < 4; ++p) { fft4(v[4 * p], v[4 * p + 1], v[4 * p + 2], v[4 * p + 3]);
        o[p] = v[4 * p]; o[4 + p] = v[4 * p + 1]; o[8 + p] = v[4 * p + 2]; o[12 + p] = v[4 * p + 3]; }
}
__device__ __forceinline__ void fft8(f32x2 (&v)[8], f32x2 (&o)[8]) {
    constexpr float C2 = 0.7071067811865476f;
    f32x2 s0 = v[0] + v[4], s1 = v[1] + v[5], s2 = v[2] + v[6], s3 = v[3] + v[7];
    f32x2 d0 = v[0] - v[4], d1 = cmul(v[1] - v[5], (f32x2){C2, -C2}), d2 = v[2] - v[6], d3 = cmul(v[3] - v[7], (f32x2){-C2, -C2});
    d2 = (f32x2){d2.y, -d2.x};
    fft4(s0, s1, s2, s3); fft4(d0, d1, d2, d3);
    o[0] = s0; o[2] = s1; o[4] = s2; o[6] = s3; o[1] = d0; o[3] = d1; o[5] = d2; o[7] = d3;
}
__device__ __forceinline__ void fft_item(const Params& p, LAS unsigned char* lds, int b, int n0) {
    unsigned char* ws = p.ws;
    const int tid = opaque_tid();
    constexpr int CS = 2176;
    LAS f32x2* Z = (LAS f32x2*)lds;
    const bf16_t* AB = (const bf16_t*)(ws + O_ABT);
#pragma unroll
    for (int i = 0; i < 2; ++i) { const int ch = tid + 512 * i, col = ch >> 8, pc = ch & 255;
        const bf16_t* src = AB + (size_t)(n0 + col) * 16384 + b * 4096 + pc * 8;
        const u32x4 a = *(const u32x4*)src, bb = *(const u32x4*)(src + 2048);
        LAS f32x2* d = Z + col * CS + pc * 8 + (pc >> 1);
#pragma unroll
        for (int q = 0; q < 4; ++q) { d[2 * q] = (f32x2){bf_lo(a[q]), -bf_lo(bb[q])}; d[2 * q + 1] = (f32x2){bf_hi(a[q]), -bf_hi(bb[q])}; } }
    __syncthreads();
    const int col = tid >> 7, j = tid & 127;
    LAS f32x2* Zc = Z + col * CS;
    f32x2 v[16], o[16];
#pragma unroll
    for (int r = 0; r < 16; ++r) { const int i = j + 128 * r; v[r] = Zc[i + (i >> 4)]; }
    fft16(v, o);
    __syncthreads();
#pragma unroll
    for (int q = 0; q < 16; ++q) Zc[17 * j + q] = o[q];
    __syncthreads();
    { const int k = j & 15;
#pragma unroll
        for (int r = 0; r < 16; ++r) { const int i = j + 128 * r; v[r] = Zc[i + (i >> 4)]; if (r) v[r] = cmul(v[r], tw_rev((float)(r * k) * (1.0f / 256.0f))); }
        fft16(v, o);
        __syncthreads();
        const int base = (j >> 4) * 256 + k;
#pragma unroll
        for (int q = 0; q < 16; ++q) { const int i = base + 16 * q; Zc[i + (i >> 4)] = o[q]; }
    }
    __syncthreads();
#pragma unroll
    for (int it = 0; it < 2; ++it) { const int jj = tid + 512 * it, c3 = jj >> 8, j3 = jj & 255;
        LAS f32x2* Z3 = Z + c3 * CS; f32x2 a[8], c[8];
#pragma unroll
        for (int r = 0; r < 8; ++r) { const int i = j3 + 256 * r; a[r] = Z3[i + (i >> 4)]; if (r) a[r] = cmul(a[r], tw_rev((float)(r * j3) * (1.0f / 2048.0f))); }
        fft8(a, c);
#pragma unroll
        for (int r = 0; r < 8; ++r) { const int i = j3 + 256 * r; Z3[i + (i >> 4)] = c[r]; } }
    __syncthreads();
    bf16_t* dst = (bf16_t*)(ws + O_CAT) + (size_t)b * SEQ * D + n0;
#pragma unroll
    for (int i = 0; i < 4; ++i) { const int pos = tid + 512 * i, sl = pos + (pos >> 4);
        constexpr float NRM = 0.02209708691207961f;
        u32x2 w; w.x = pk2(Z[sl].x * NRM, Z[CS + sl].x * NRM); w.y = pk2(Z[2 * CS + sl].x * NRM, Z[3 * CS + sl].x * NRM);
        *(u32x2*)(dst + (size_t)pos * D) = w; }
    __syncthreads();
}

__device__ __forceinline__ void phase_mix(const Params& p, LAS unsigned char* lds, LAS int* s_item, int l, int rep) {
    unsigned char* ws = p.ws;
    const bool cx = (l == 0);
    const int nA = 64, nFF = 64, nFC = cx ? 1 : 0, nAC = cx ? 8 : 0, nCV = cx ? 36 : 32;
    const int total = nA + nFF + nFC + nAC + nCV;
    const int xcc = (int)(xb_xcc_id() & 7u);
    unsigned live = 0xffu;
    for (int k = 0; k < 8; ++k) {
        const int x = (xcc + k) & 7;
        unsigned* ctr = (unsigned*)(ws + O_MISC) + 16 + (l * 8 + x) * 8;
        if (k == 1) {
            __syncthreads();
            if (threadIdx.x == 0) {
                const unsigned* cb = (const unsigned*)(ws + O_MISC) + 16 + (l * 8) * 8; unsigned c0, c1, c2, c3, c4, c5, c6, c7;
                asm volatile("global_load_dword %0, %8, off sc1\n\t" "global_load_dword %1, %8, off offset:32 sc1\n\t" "global_load_dword %2, %8, off offset:64 sc1\n\t"
                             "global_load_dword %3, %8, off offset:96 sc1\n\t" "global_load_dword %4, %8, off offset:128 sc1\n\t" "global_load_dword %5, %8, off offset:160 sc1\n\t"
                             "global_load_dword %6, %8, off offset:192 sc1\n\t" "global_load_dword %7, %8, off offset:224 sc1\n\t" "s_waitcnt vmcnt(0)"
                             : "=&v"(c0), "=&v"(c1), "=&v"(c2), "=&v"(c3), "=&v"(c4), "=&v"(c5), "=&v"(c6), "=&v"(c7) : "v"(cb) : "memory");
                const unsigned t = (unsigned)total;
                *s_item = (int)((c0 < t ? 1u : 0u) | (c1 < t ? 2u : 0u) | (c2 < t ? 4u : 0u) | (c3 < t ? 8u : 0u) | (c4 < t ? 16u : 0u) | (c5 < t ? 32u : 0u) | (c6 < t ? 64u : 0u) | (c7 < t ? 128u : 0u));
            }
            __syncthreads();
            live = (unsigned)*s_item;
        }
        if (!((live >> x) & 1u)) continue;
        for (;;) {
            __syncthreads();
            if (threadIdx.x == 0) *s_item = (int)atomicAdd(ctr, 1u);
            __syncthreads();
            int it = *s_item;
            if (it >= total) break;
            if (it < nA) { const int qb = it & 15, bh = (it >> 4) * 8 + x; attn_item(p, lds, l, bh >> 3, bh & 7, qb, false); continue; }
            it -= nA;
            if (it < nFF) { const int id = x * 64 + it; fft_item(p, lds, id >> 7, (id & 127) * 4); continue; }
            it -= nFF;
            if (it < nFC) { const int b = x >> 1, pn = x & 1;
                SchedOne S; S.u.a = (const char*)(ws + O_DFTC); S.u.b = (const char*)(ws + O_ABTC) + ((size_t)pn * 256 * 2048 + b * 512) * 2;
                S.u.nt = 8; S.u.kind = 0; S.u.pm = 0; S.u.pn = pn;
                EpiBf16<0> E; E.O = (bf16_t*)(ws + O_CAT) + (size_t)(NLAT + b * CTXL) * D; E.ldc = D;
                pg8::gemm_phase(lds, 512, 2048, S, E);
                continue; }
            it -= nFC;
            if (it < nAC) { const int qb = it & 1, bh = (it >> 1) * 8 + x; attn_item(p, lds, l, bh >> 3, bh & 7, qb, true); continue; }
            it -= nAC;
            { const int id = x * nCV + it; if (id < 256) conv_item(p, lds, l, id >> 6, id & 63); else { const int j = id - 256; conv_item(p, lds, l, 4 + (j >> 3), j & 7); } }
        }
    }
}

constexpr int NPH = 16;
__global__ void __launch_bounds__(512, 2) mega(Params p) {
    extern __shared__ __attribute__((aligned(16))) unsigned char shm[];
    LAS unsigned char* lds = (LAS unsigned char*)shm;
    unsigned char* ws = p.ws;
    const int G = gridDim.x, c = blockIdx.x;
    const float* MOD = (const float*)(ws + O_MOD);
    volatile LAS unsigned* xst = (volatile LAS unsigned*)(lds + LDS_BYTES + 16);
    if (threadIdx.x == 0) { xst[0] = 0u; xst[1] = 0u; }
    __syncthreads();
    const XcdBarrier xb = xcd_barrier_post((unsigned*)(ws + O_BAR), xst);
    if (p.ph_lo < 0) cg::this_grid().sync();
    for (int ph = p.ph_lo; ph < p.ph_hi; ++ph) {
        if (ph > p.ph_lo) xcd_barrier(xb);
        if (ph == 0) { phase_prep(p, lds); if (PROBE_DUP & 1) { __syncthreads(); phase_prep(p, lds); } continue; }
        if (ph == 1) {
            {
                for (int it = c; it < 64; it += G) { const int l = it >> 5, g = (it >> 3) & 3, pn = it & 7;
                    SchedOne S; S.u.a = (const char*)(ws + O_MTP + l * SZ_MTP) + (size_t)g * 256 * 256 * 2; S.u.b = (const char*)(ws + O_WINF + l * SZ_WINF) + ((size_t)pn * 256 * 640 + g * 128) * 2;
                    S.u.nt = 4; S.u.kind = 0; S.u.pm = g; S.u.pn = pn;
                    EpiBf16<0> E; E.O = (bf16_t*)(ws + O_WINT + l * SZ_WINT); E.ldc = 2048;
                    pg8::gemm_phase(lds, 256, 640, S, E); }
                for (int it = (G >= 96 ? (c >= 64 ? c - 64 : c + G - 64) : c); it < 32; it += G) { const int l = it >> 4, pm = (it >> 1) & 7, pn = it & 1;
                    SchedOne S; S.u.a = (const char*)(ws + O_WTMP + l * SZ_WTMP) + (size_t)pm * 256 * 512 * 2; S.u.b = (const char*)(ws + O_WPW + l * SZ_WPW) + (size_t)pn * 256 * 512 * 2;
                    S.u.nt = 8; S.u.kind = 0; S.u.pm = pm; S.u.pn = pn;
                    EpiBf16<0> E; E.O = (bf16_t*)(ws + O_WOUTF + l * SZ_WOUTF) + 512; E.ldc = 2048;
                    pg8::gemm_phase(lds, 512, 512, S, E); }
            }
            RowArgs a{}; a.mode = 0; a.hasH = true; a.nrows = NROW; a.xlat = p.x; a.xctx = p.ctx; a.gn = p.g_pre_mix; a.modn = MOD; a.sh_off = 0; a.sc_off = 2048; a.H = (bf16_t*)(ws + O_H);
            phase_rows(a); if (PROBE_DUP & 8) { phase_rows(a); phase_rows(a); for (int q = 0; q < 8; ++q) xcd_barrier(xb); } continue;
        }
        const int l = (ph - 2) / 7, sp = (ph - 2) % 7;
        for (int rep = 0; rep < (((PROBE_DUP & 2) && (sp == 0 || sp == 2 || sp == 4 || sp == 5)) ? 2 : 1); ++rep) {
        const bool cx = (l == 0);
        const float* xl = cx ? p.x : p.out; const float* xc = cx ? p.ctx : (const float*)(ws + O_CX);
        if (sp == 0) { SchedP2 S; S.H = (const char*)(ws + O_H); S.W = (const char*)(ws + O_WINT + l * SZ_WINT); S.G = G; S.c = c; EpiP2 E; E.ws = ws; E.layer = l; pg8::gemm_phase(lds, 2048, 2048, S, E); }
        else if (sp == 1) { phase_mix(p, lds, (LAS int*)(lds + LDS_BYTES), l, 0); }
        else if (sp == 2) { SchedGrid S; S.A = (const char*)(ws + O_CAT); S.B = (const char*)(ws + O_WOUTF + l * SZ_WOUTF); S.lda = 2048; S.ldb = 2048; S.nM = 32; S.nN = 8; S.nt = 32; S.nsplit = cx ? 8 : 0; S.G = G; S.c = c;
            EpiY E; E.Y = (bf16_t*)(ws + O_Y); E.YP = (bf16_t*)(ws + O_YP); E.split_stride = (size_t)NCTX * D; pg8::gemm_phase(lds, 2048, 2048, S, E); }
        else if (sp == 3) { RowArgs a{}; a.mode = 1; a.hasH = true; a.nrows = cx ? NROW : NLAT; a.xlat = xl; a.xctx = xc; a.olat = p.out; a.octx = (float*)(ws + O_CX);
            a.Y = (const bf16_t*)(ws + O_Y); a.YP = (const bf16_t*)(ws + O_YP); a.bias = (const float*)(ws + O_BO) + l * 2048; a.gpost = p.g_post_mix + l * D; a.gn = p.g_pre_mlp + l * D;
            a.mod = MOD + (size_t)l * 5 * 12288; a.modn = a.mod; a.gate_off = 4096; a.sh_off = 6144; a.sc_off = 8192; a.H = (bf16_t*)(ws + O_H); a.x16 = (const bf16_t*)(ws + O_X16); a.o16 = (bf16_t*)(ws + O_X16); a.in16 = !cx; a.out16 = true; phase_rows(a); }
        else if (sp == 4) { SchedGrid S; S.A = (const char*)(ws + O_H); S.B = (const char*)(ws + O_WMI + l * SZ_WMI); S.lda = 2048; S.ldb = 2048; S.nM = cx ? 36 : 32; S.nN = 32; S.nt = 32; S.nsplit = 0; S.G = G; S.c = c;
            EpiBf16<1> E; E.O = (bf16_t*)(ws + O_T); E.ldc = DFF; pg8::gemm_phase(lds, 2048, 2048, S, E);
            if (cx && G == 256 ? c >= 128 : false) {
                LAS float* scr = (LAS float*)lds;
                for (int j = c - 128; j < 2048; j += 128) {
                    if (j < 1024) { const int kt = j >> 7, ntile = j & 127; tr_tile(p.w_mlp_in + (size_t)2048 * 8192, 8192, kt * 256, ntile * 64, (bf16_t*)(ws + O_WMI + SZ_WMI), 2048, kt * 256, RmId(), scr); }
                    else { const int q = j - 1024, kt = q >> 5, ntile = q & 31; tr_tile(p.w_mlp_out + (size_t)8192 * 2048, 2048, kt * 256, ntile * 64, (bf16_t*)(ws + O_WMO + SZ_WMO), 8192, kt * 256, RmId(), scr); }
                }
            } else if (cx && G != 256) {
                LAS float* scr = (LAS float*)lds;
                for (int j = c; j < 2048; j += G) {
                    if (j < 1024) { const int kt = j >> 7, ntile = j & 127; tr_tile(p.w_mlp_in + (size_t)2048 * 8192, 8192, kt * 256, ntile * 64, (bf16_t*)(ws + O_WMI + SZ_WMI), 2048, kt * 256, RmId(), scr); }
                    else { const int q = j - 1024, kt = q >> 5, ntile = q & 31; tr_tile(p.w_mlp_out + (size_t)8192 * 2048, 2048, kt * 256, ntile * 64, (bf16_t*)(ws + O_WMO + SZ_WMO), 8192, kt * 256, RmId(), scr); }
                }
            } }
        else if (sp == 5) { SchedGrid S; S.A = (const char*)(ws + O_T); S.B = (const char*)(ws + O_WMO + l * SZ_WMO); S.lda = 8192; S.ldb = 8192; S.nM = 32; S.nN = 8; S.nt = 128; S.nsplit = cx ? 8 : 0; S.G = G; S.c = c;
            EpiY E; E.Y = (bf16_t*)(ws + O_Y); E.YP = (bf16_t*)(ws + O_YP); E.split_stride = (size_t)NCTX * D; pg8::gemm_phase(lds, 8192, 8192, S, E); }
        else { RowArgs a{}; a.mode = 1; a.hasH = cx; a.nrows = cx ? NROW : NLAT; a.xlat = p.out; a.xctx = (const float*)(ws + O_CX); a.olat = p.out; a.octx = (float*)(ws + O_CX);
            a.Y = (const bf16_t*)(ws + O_Y); a.YP = (const bf16_t*)(ws + O_YP); a.bias = nullptr; a.gpost = p.g_post_mlp + l * D; a.gn = p.g_pre_mix + (l + 1 < 2 ? l + 1 : l) * D;
            a.mod = MOD + (size_t)l * 5 * 12288; a.modn = MOD + (size_t)(l + 1 < 2 ? l + 1 : l) * 5 * 12288; a.gate_off = 10240; a.sh_off = 0; a.sc_off = 2048; a.H = (bf16_t*)(ws + O_H); a.x16 = (const bf16_t*)(ws + O_X16); a.o16 = (bf16_t*)(ws + O_X16); a.in16 = true; a.out16 = cx; phase_rows(a); }
        }
    }
}

extern "C" void kernel_launch(void* const* d_in, const int* in_sizes, int n_in, void* d_out, int out_size, void* d_ws, size_t ws_size, hipStream_t stream) {
    static int grid = 0;
    if (grid == 0) {
        if (n_in != 26 || ws_size < WS_END) { fprintf(stderr, "kernel_launch: unexpected n_in %d or workspace %zu < %zu\n", n_in, ws_size, (size_t)WS_END); }
        int dev = 0, cus = 0, per_cu = 0;
        (void)hipGetDevice(&dev); (void)hipDeviceGetAttribute(&cus, hipDeviceAttributeMultiprocessorCount, dev);
        (void)hipFuncSetAttribute((const void*)mega, hipFuncAttributeMaxDynamicSharedMemorySize, LDS_TOTAL);
        (void)hipOccupancyMaxActiveBlocksPerMultiprocessor(&per_cu, (const void*)mega, NTHR, LDS_TOTAL);
        if (per_cu < 1) { fprintf(stderr, "kernel_launch: occupancy query says %d blocks/CU\n", per_cu); per_cu = 1; }
        (void)hipGetLastError();
        grid = cus * 1;
    }
    (void)hipMemsetAsync((unsigned char*)d_ws + O_BAR, 0, 16384, stream);
    Params p{};
    const float** f = (const float**)&p;
    for (int i = 0; i < 26; ++i) f[i] = (const float*)d_in[i];
    p.out = (float*)d_out; p.ws = (unsigned char*)d_ws;
#if MK_MULTI
    for (int ph = 0; ph < NPH; ++ph) { p.ph_lo = ph; p.ph_hi = ph + 1; hipLaunchKernelGGL(mega, dim3(grid), dim3(NTHR), LDS_TOTAL, stream, p); }
#else
    p.ph_lo = 0; p.ph_hi = NPH;
    void* args[] = {&p};
    hipError_t e = hipLaunchCooperativeKernel((const void*)mega, dim3(grid), dim3(NTHR), args, LDS_TOTAL, stream);
    if (e != hipSuccess) fprintf(stderr, "cooperative launch failed: %s (grid %d)\n", hipGetErrorString(e), grid);
#endif
}
```

```cpp
#include <hip/hip_runtime.h>
#include <hip/hip_cooperative_groups.h>
#include <cstdio>
namespace cg = cooperative_groups;

#ifndef MK_MULTI
#define MK_MULTI 0
#endif

#ifndef PROBE_DUP
#define PROBE_DUP 0
#endif
#define LAS __attribute__((address_space(3)))
typedef unsigned short bf16_t;
typedef short bf16x8 __attribute__((ext_vector_type(8)));
typedef float f32x4 __attribute__((ext_vector_type(4)));
typedef float f32x16 __attribute__((ext_vector_type(16)));
typedef unsigned u32x4 __attribute__((ext_vector_type(4)));
typedef unsigned u32x2 __attribute__((ext_vector_type(2)));

constexpr int D = 2048, NB = 4, SEQ = 2048, CTXL = 256, NLAT = NB * SEQ, NCTX = NB * CTXL, NROW = NLAT + NCTX;
constexpr int DFF = 8192, LK = CTXL + SEQ, INC = 4608, NH = 8;
constexpr float EPS = 1e-6f;
constexpr float QSCALE = 0.125f * 1.4426950408889634f;
constexpr int NTHR = 512;
constexpr int LDS_BYTES = 131072;
constexpr int LDS_TOTAL = LDS_BYTES + 64;

constexpr size_t al256(size_t x) { return (x + 255) & ~(size_t)255; }
constexpr size_t SZ_WINT = (size_t)5120 * 2048 * 2, SZ_WINF = (size_t)2048 * 640 * 2, SZ_MTP = (size_t)1024 * 256 * 2, SZ_WOUTF = (size_t)2048 * 2048 * 2,
                 SZ_WTMP = (size_t)2048 * 512 * 2, SZ_WPW = (size_t)512 * 512 * 2, SZ_WMI = (size_t)8192 * 2048 * 2, SZ_WMO = SZ_WMI;
constexpr size_t O_WINT = 0;
constexpr size_t O_WINF = O_WINT + 2 * SZ_WINT;
constexpr size_t O_MTP = O_WINF + 2 * SZ_WINF;
constexpr size_t O_WOUTF = O_MTP + 2 * SZ_MTP;
constexpr size_t O_WTMP = O_WOUTF + 2 * SZ_WOUTF;
constexpr size_t O_WPW = O_WTMP + 2 * SZ_WTMP;
constexpr size_t O_WMI = O_WPW + 2 * SZ_WPW;
constexpr size_t O_WMO = O_WMI + 2 * SZ_WMI;
constexpr size_t O_DFT = O_WMO + 2 * SZ_WMO;
constexpr size_t O_DFTC = O_DFT + (size_t)2048 * 4096 * 2;
constexpr size_t O_MOD = O_DFTC + (size_t)256 * 512 * 2;
constexpr size_t O_BO = O_MOD + al256((size_t)2 * 5 * 12288 * 4);
constexpr size_t O_ROPE = O_BO + (size_t)2 * 2048 * 4;
constexpr size_t O_MISC = O_ROPE + (size_t)2048 * 64 * 4;
constexpr size_t O_KMAX = O_MISC + 1024;
constexpr size_t O_CX = O_MISC + 2048;
constexpr size_t O_H = O_CX + (size_t)NCTX * D * 4;
constexpr size_t O_ABT = O_H + (size_t)NROW * D * 2;
constexpr size_t O_ABTC = O_ABT + (size_t)512 * 16384 * 2;
constexpr size_t O_Z = O_ABTC + (size_t)512 * 2048 * 2;
constexpr size_t O_Q = O_Z + (size_t)NROW * 512 * 2;
constexpr size_t O_KK = O_Q + (size_t)NROW * 1024 * 2;
constexpr size_t O_VT = O_KK + (size_t)NB * NH * 2 * LK * 64 * 2;
constexpr size_t O_CAT = O_VT + (size_t)NB * NH * 128 * LK * 2;
constexpr size_t O_Y = O_CAT + (size_t)NROW * D * 2;
constexpr size_t O_YP = O_Y + (size_t)NROW * D * 4;
constexpr size_t O_T = O_YP + (size_t)8 * NCTX * D * 4;
constexpr size_t O_BAR = O_T + (size_t)NROW * DFF * 2;
constexpr size_t O_X16 = O_BAR + 16384;
constexpr size_t WS_END = O_X16 + (size_t)NROW * D * 2;

struct Params {
    const float *x, *c, *ctx, *c_ctx, *w_ada, *b_ada, *g_pre_mix, *g_post_mix, *g_pre_mlp, *g_post_mlp, *w_in, *w_out, *w_fourier, *w_dw, *b_dw,
        *g_conv_ln, *b_conv_ln, *w_conv_pw, *b_conv_pw, *lq1, *lk1, *lq2, *lk2, *g_subln, *w_mlp_in, *w_mlp_out;
    float* out; unsigned char* ws; int ph_lo, ph_hi;
};

__device__ __forceinline__ unsigned pk2(float lo, float hi) { unsigned r; asm volatile("v_cvt_pk_bf16_f32 %0, %1, %2" : "=v"(r) : "v"(lo), "v"(hi)); return r; }
__device__ __forceinline__ float bf_lo(unsigned v) { return __uint_as_float(v << 16); }
__device__ __forceinline__ float bf_hi(unsigned v) { return __uint_as_float(v & 0xffff0000u); }
__device__ __forceinline__ float wave_sum(float v) {
#pragma unroll
    for (int o = 1; o < 64; o <<= 1) v += __shfl_xor(v, o);
    return v;
}
__device__ __forceinline__ int opaque_tid() { int t = threadIdx.x; asm volatile("" : "+v"(t)); return t; }
__device__ __forceinline__ float fsigmoid(float x) { return __builtin_amdgcn_rcpf(1.0f + __expf(-x)); }
__device__ __forceinline__ float cos_rev(float r) { return __builtin_amdgcn_cosf(r); }
__device__ __forceinline__ float sin_rev(float r) { return __builtin_amdgcn_sinf(r); }


#define XB_TMO      128
#define XB_XCNT(j)  (256  + 64 * (j))
#define XB_XSUB(j)  (1280 + 64 * (j))
#define XB_XGEN(j)  (2304 + 64 * (j))
#define XB_TOP      3328
#define XB_TOPGEN   3392
#define XCD_BAR_WORDS 3456
#define XB_SPIN_CAP (1u << 22)
__device__ __forceinline__ unsigned xb_ld(unsigned* p)              { return __hip_atomic_load(p, __ATOMIC_RELAXED, __HIP_MEMORY_SCOPE_AGENT); }
__device__ __forceinline__ unsigned xb_add(unsigned* p, unsigned v) { return __hip_atomic_fetch_add(p, v, __ATOMIC_RELAXED, __HIP_MEMORY_SCOPE_AGENT); }
__device__ __forceinline__ unsigned xb_xcc_id() { return (unsigned)__builtin_amdgcn_s_getreg((3 << 11) | 20) & 0xFu; }
#define XB_SPIN(cond, bar) do { unsigned _sp = 0; while (cond) { __builtin_amdgcn_s_sleep(1); \
    if ((++_sp & 255u) == 0u) { if (xb_ld(&(bar)[XB_TMO])) break; if (_sp > XB_SPIN_CAP) { atomicAdd(&(bar)[XB_TMO], 1u); break; } } } } while (0)
struct XcdBarrier { unsigned* bar; unsigned x; volatile LAS unsigned* st; };
__device__ __forceinline__ XcdBarrier xcd_barrier_post(unsigned* bar, volatile LAS unsigned* st) {
    XcdBarrier b; b.bar = bar; b.x = xb_xcc_id(); b.st = st;
    if (threadIdx.x == 0) (void)xb_add(&bar[XB_XCNT(b.x)], 1u);
    return b;
}
__device__ __forceinline__ void xcd_barrier_complete(unsigned* bar, unsigned x, unsigned& nloc, unsigned& nx) {
    const unsigned G = gridDim.x * gridDim.y * gridDim.z;
    unsigned sum, cnt, mine, sp = 0u;
    for (;;) {
        sum = 0u; cnt = 0u; mine = 0u;
        unsigned cc[16];
        {
            const unsigned* cb = &bar[XB_XCNT(0)];
            asm volatile(
                "global_load_dword %0, %16, off sc1\n\t"            "global_load_dword %1, %16, off offset:256 sc1\n\t"
                "global_load_dword %2, %16, off offset:512 sc1\n\t" "global_load_dword %3, %16, off offset:768 sc1\n\t"
                "global_load_dword %4, %16, off offset:1024 sc1\n\t" "global_load_dword %5, %16, off offset:1280 sc1\n\t"
                "global_load_dword %6, %16, off offset:1536 sc1\n\t" "global_load_dword %7, %16, off offset:1792 sc1\n\t"
                "global_load_dword %8, %16, off offset:2048 sc1\n\t" "global_load_dword %9, %16, off offset:2304 sc1\n\t"
                "global_load_dword %10, %16, off offset:2560 sc1\n\t" "global_load_dword %11, %16, off offset:2816 sc1\n\t"
                "global_load_dword %12, %16, off offset:3072 sc1\n\t" "global_load_dword %13, %16, off offset:3328 sc1\n\t"
                "global_load_dword %14, %16, off offset:3584 sc1\n\t" "global_load_dword %15, %16, off offset:3840 sc1\n\t"
                "s_waitcnt vmcnt(0)"
                : "=&v"(cc[0]), "=&v"(cc[1]), "=&v"(cc[2]), "=&v"(cc[3]), "=&v"(cc[4]), "=&v"(cc[5]), "=&v"(cc[6]), "=&v"(cc[7]),
                  "=&v"(cc[8]), "=&v"(cc[9]), "=&v"(cc[10]), "=&v"(cc[11]), "=&v"(cc[12]), "=&v"(cc[13]), "=&v"(cc[14]), "=&v"(cc[15])
                : "v"(cb) : "memory");
        }
#pragma unroll
        for (unsigned j = 0; j < 16; ++j) { const unsigned c = cc[j]; sum += c; cnt += (c > 0u) ? 1u : 0u; mine = (j == x) ? c : mine; }
        if (sum == G) break;
        __builtin_amdgcn_s_sleep(1);
        if ((++sp & 255u) == 0u) { if (xb_ld(&bar[XB_TMO])) break; if (sp > XB_SPIN_CAP) { atomicAdd(&bar[XB_TMO], 1u); break; } }
    }
    nloc = mine > 0u ? mine : 1u; nx = cnt > 0u ? cnt : 1u;
}
__device__ __forceinline__ void xcd_barrier(const XcdBarrier& b) {
    asm volatile("s_waitcnt vmcnt(0)" ::: "memory");
    __syncthreads();
    if (threadIdx.x == 0) {
        unsigned* bar = b.bar;
        __builtin_amdgcn_s_waitcnt(0);
        unsigned nloc = b.st[0], nx = b.st[1];
        if (nloc == 0u) { xcd_barrier_complete(bar, b.x, nloc, nx); b.st[0] = nloc; b.st[1] = nx; }
        const unsigned old = xb_add(&bar[XB_XSUB(b.x)], 1u);
        const unsigned gen = old / nloc;
        if (old + 1u == (gen + 1u) * nloc) {
            __builtin_amdgcn_fence(__ATOMIC_RELEASE, "agent");
            asm volatile("s_waitcnt vmcnt(0)" ::: "memory");
            const unsigned og = xb_add(&bar[XB_TOP], 1u);
            const unsigned tg = og / nx;
            if (og + 1u == (tg + 1u) * nx) xb_add(&bar[XB_TOPGEN], 1u);
            else XB_SPIN(xb_ld(&bar[XB_TOPGEN]) == tg, bar);
            __builtin_amdgcn_fence(__ATOMIC_ACQUIRE, "agent");
            xb_add(&bar[XB_XGEN(b.x)], 1u);
            asm volatile("s_waitcnt vmcnt(0)" ::: "memory");
        } else {
            XB_SPIN(xb_ld(&bar[XB_XGEN(b.x)]) == gen, bar);
            __builtin_amdgcn_fence(__ATOMIC_ACQUIRE, "agent");
            asm volatile("s_waitcnt vmcnt(0)" ::: "memory");
        }
    }
    __syncthreads();
}

namespace pg8 {
constexpr int BM = 256, BK = 64, HALF = 128, HTB = HALF * BK * 2;
__device__ __forceinline__ int lds_byte(int r, int c) { const int st = (r >> 4) * 2 + (c >> 5), rr = r & 15, cc = c & 31, ob = rr * 64 + cc * 2; return st * 1024 + (ob ^ (((ob >> 9) & 1) << 5)); }
__device__ __forceinline__ void stage_rc(int b, int& R, int& C) { const int st = b / 1024, sb = b % 1024, swz = sb ^ (((sb >> 9) & 1) << 5); R = (st >> 1) * 16 + swz / 64; C = (st & 1) * 32 + (swz % 64) / 2; }
__device__ __forceinline__ int perm32(int rho) { const int n = rho >> 4, i = rho & 15; return 8 * (i >> 2) + 4 * n + (i & 3); }

struct Unit { const char* a; const char* b; int nt, kind, pm, pn; };

template <class Epi, class Sched>
__device__ __forceinline__ void gemm_phase(LAS unsigned char* lds, const int lda, const int ldb, const Sched& S, const Epi& E) {
    const int tid = opaque_tid(), wid = __builtin_amdgcn_readfirstlane(tid >> 6), lane = tid & 63, wr = wid >> 2, wc = wid & 3, fr = lane & 15, fq = lane >> 4;
    unsigned voffA[2], voffB[2];
#pragma unroll
    for (int i = 0; i < 2; ++i) { int R, C; stage_rc(tid * 16 + i * 8192, R, C); const int Rb = Epi::PERM ? ((R & ~31) + perm32(R & 31)) : R;
        voffA[i] = (unsigned)(R * lda + C) * 2u; voffB[i] = (unsigned)(Rb * ldb + C) * 2u; }
    const size_t kstep = (size_t)(BK * 2);
    const size_t hstepA = (size_t)HALF * lda * 2, hstepB = (size_t)HALF * ldb * 2;
    const unsigned ldsw = (unsigned)wid * 1024u;
    const int aoff = lds_byte(wr * 64 + fr, fq * 8), boff = lds_byte(wc * 32 + fr, fq * 8);
#define PG8_SA(b, h) (((b) * 2 + (h)) * HTB)
#define PG8_SB(b, h) ((4 + (b) * 2 + (h)) * HTB)
#define PG8_STAGE(bufoff, gbase, voff) do { _Pragma("unroll") for (int _i = 0; _i < 2; ++_i) \
        __builtin_amdgcn_global_load_lds((const unsigned*)((const char*)(gbase) + (voff)[_i]), (LAS unsigned*)(lds + (bufoff) + ldsw + _i * 8192), 16, 0, 0); } while (0)
#define PG8_LDA(dst, b, h) do { _Pragma("unroll") for (int m = 0; m < 4; ++m) _Pragma("unroll") for (int k = 0; k < 2; ++k) dst[m][k] = *(const LAS bf16x8*)(lds + PG8_SA(b, h) + aoff + m * 2048 + k * 1024); } while (0)
#define PG8_LDB(dst, b, h) do { _Pragma("unroll") for (int n = 0; n < 2; ++n) _Pragma("unroll") for (int k = 0; k < 2; ++k) dst[n][k] = *(const LAS bf16x8*)(lds + PG8_SB(b, h) + boff + n * 2048 + k * 1024); } while (0)
#define PG8_MMA(ai, bj, At, Bt) do { __builtin_amdgcn_s_setprio(1); _Pragma("unroll") for (int m = 0; m < 4; ++m) _Pragma("unroll") for (int n = 0; n < 2; ++n) _Pragma("unroll") for (int k = 0; k < 2; ++k) \
        acc[ai][bj][m][n] = __builtin_amdgcn_mfma_f32_16x16x32_bf16(Bt[n][k], At[m][k], acc[ai][bj][m][n], 0, 0, 0); __builtin_amdgcn_s_setprio(0); } while (0)
#define PG8_WAIT_V(n) asm volatile("s_waitcnt vmcnt(" #n ")" ::: "memory")
#define PG8_WAIT_L(n) asm volatile("s_waitcnt lgkmcnt(" #n ")" ::: "memory")
#define PG8_BAR __builtin_amdgcn_s_barrier()
#define PG8_SCHED __builtin_amdgcn_sched_barrier(0)
    Unit cur, nxt; int ui = 0;
    if (!S.next(0, cur)) return;
    f32x4 acc[2][2][4][2];
#pragma unroll
    for (int a = 0; a < 2; ++a)
#pragma unroll
        for (int b = 0; b < 2; ++b)
#pragma unroll
            for (int m = 0; m < 4; ++m)
#pragma unroll
                for (int n = 0; n < 2; ++n) acc[a][b][m][n] = (f32x4){0.f, 0.f, 0.f, 0.f};
    bf16x8 At[4][2], B0[2][2], B1[2][2];
    const char* cA = cur.a; const char* cB = cur.b;
    PG8_STAGE(PG8_SB(0, 0), cB, voffB); PG8_STAGE(PG8_SA(0, 0), cA, voffA); PG8_STAGE(PG8_SB(0, 1), cB + hstepB, voffB); PG8_STAGE(PG8_SA(0, 1), cA + hstepA, voffA);
    PG8_STAGE(PG8_SB(1, 0), cB + kstep, voffB); PG8_STAGE(PG8_SA(1, 0), cA + kstep, voffA); PG8_STAGE(PG8_SB(1, 1), cB + hstepB + kstep, voffB);
    if (wr == 1) PG8_BAR;
    PG8_WAIT_V(10); PG8_BAR;
    PG8_WAIT_V(6); PG8_BAR;
    for (;;) {
        const bool has_next = S.next(ui + 1, nxt);
        const char* nA = has_next ? nxt.a : cA; const char* nB = has_next ? nxt.b : cB;
        const int nt = cur.nt;
        for (int t = 0; t < nt; t += 2) {
            const bool last = (t == nt - 2);
            const char* a1 = cA + (size_t)(t + 1) * kstep;
            const char* a2 = last ? nA : cA + (size_t)(t + 2) * kstep; const char* b2 = last ? nB : cB + (size_t)(t + 2) * kstep;
            const char* a3 = a2 + kstep; const char* b3 = b2 + kstep;
            PG8_LDB(B0, 0, 0); PG8_SCHED; PG8_LDA(At, 0, 0); PG8_STAGE(PG8_SA(1, 1), a1 + hstepA, voffA);
            PG8_WAIT_L(8); PG8_BAR; PG8_WAIT_L(0); PG8_MMA(0, 0, At, B0); PG8_BAR; PG8_SCHED;
            PG8_LDB(B1, 0, 1); PG8_STAGE(PG8_SB(0, 0), b2, voffB);
            PG8_BAR; PG8_WAIT_L(0); PG8_MMA(0, 1, At, B1); PG8_BAR;
            PG8_LDA(At, 0, 1); PG8_STAGE(PG8_SA(0, 0), a2, voffA);
            PG8_BAR; PG8_WAIT_L(0); PG8_MMA(1, 0, At, B0); PG8_BAR; PG8_SCHED;
            PG8_STAGE(PG8_SB(0, 1), b2 + hstepB, voffB);
            PG8_WAIT_V(6); PG8_BAR; PG8_MMA(1, 1, At, B1); PG8_BAR;
            PG8_LDB(B0, 1, 0); PG8_SCHED; PG8_LDA(At, 1, 0); PG8_STAGE(PG8_SA(0, 1), a2 + hstepA, voffA);
            PG8_WAIT_L(8); PG8_BAR; PG8_WAIT_L(0); PG8_MMA(0, 0, At, B0); PG8_BAR; PG8_SCHED;
            PG8_LDB(B1, 1, 1); PG8_STAGE(PG8_SB(1, 0), b3, voffB);
            PG8_BAR; PG8_WAIT_L(0); PG8_MMA(0, 1, At, B1); PG8_BAR;
            PG8_LDA(At, 1, 1); PG8_STAGE(PG8_SA(1, 0), a3, voffA);
            PG8_BAR; PG8_WAIT_L(0); PG8_MMA(1, 0, At, B0); PG8_BAR; PG8_SCHED;
            PG8_STAGE(PG8_SB(1, 1), b3 + hstepB, voffB);
            PG8_WAIT_V(6); PG8_BAR; PG8_MMA(1, 1, At, B1); PG8_BAR;
        }
        { int lane2; asm volatile("v_mov_b32 %0, %1" : "=v"(lane2) : "v"(lane));
          E(acc, cur, wr, wc, lane2 & 15, lane2 >> 4); }
        if (!has_next) break;
#pragma unroll
        for (int a = 0; a < 2; ++a)
#pragma unroll
            for (int b = 0; b < 2; ++b)
#pragma unroll
                for (int m = 0; m < 4; ++m)
#pragma unroll
                    for (int n = 0; n < 2; ++n) acc[a][b][m][n] = (f32x4){0.f, 0.f, 0.f, 0.f};
        cur = nxt; cA = nA; cB = nB; ++ui;
    }
    PG8_WAIT_V(0);
    if (wr == 0) PG8_BAR;
    PG8_BAR;
#undef PG8_SA
#undef PG8_SB
#undef PG8_STAGE
#undef PG8_LDA
#undef PG8_LDB
#undef PG8_MMA
#undef PG8_WAIT_V
#undef PG8_WAIT_L
#undef PG8_BAR
#undef PG8_SCHED
}
__device__ __forceinline__ int xcd_remap(int wgid, int nwg) { const int q = nwg / 8, r = nwg % 8, xcd = wgid % 8, off = wgid / 8; return (xcd < r ? xcd * (q + 1) : r * (q + 1) + (xcd - r) * q) + off; }
__device__ __forceinline__ void grid_decode(int w, int nM, int nN, int& pm, int& pn) { const int nig = 8 * nN, gid = w / nig, fm = gid * 8, gsz = (nM - fm) < 8 ? (nM - fm) : 8; pm = fm + ((w % nig) % gsz); pn = (w % nig) / gsz; }
}
using pg8::Unit;

enum { K_TFOLD = 0, K_TV = 1, K_NGLU = 2, K_NQ = 3, K_NK = 4 };
struct SchedP2 {
    const char* H; const char* W; int G, c;
    __device__ __forceinline__ bool next(int i, Unit& u) const {
        const int L = i * G + c; if (L >= 720) return false;
        int w = pg8::xcd_remap(L, 720); int pm, pn;
        { const int x = w / 90, j = w - 90 * x; w = j < 36 ? 36 * x + j : 288 + 54 * x + (j - 36); }
        if (w < 288) { pg8::grid_decode(w, 8, 36, pm, pn); u.kind = pm < 4 ? K_TFOLD : K_TV; u.a = W + (size_t)pm * 256 * 4096; u.b = H + (size_t)pn * 256 * 4096; }
        else { w -= 288; pg8::grid_decode(w, 36, 12, pm, pn); u.kind = K_NGLU + (pn >> 2); u.a = H + (size_t)pm * 256 * 4096; u.b = W + (size_t)(2048 + pn * 256) * 4096; }
        u.pm = pm; u.pn = pn; u.nt = 32; return true;
    }
};
struct SchedGrid {
    const char* A; const char* B; int lda, ldb, nM, nN, nt, nsplit  , G, c;
    __device__ __forceinline__ bool next(int i, Unit& u) const {
        const int nmain = nM * nN, ntot = nmain + 4 * nN * nsplit;
        const int L = i * G + c; if (L >= ntot) return false;
        if (L < nmain) { const int w = pg8::xcd_remap(L, nmain); int pm, pn; pg8::grid_decode(w, nM, nN, pm, pn);
            u.kind = 0; u.pm = pm; u.pn = pn; u.nt = nt; u.a = A + (size_t)pm * 256 * lda * 2; u.b = B + (size_t)pn * 256 * ldb * 2; }
        else { const int idx = L - nmain, s = idx & 7, rest = idx >> 3, pn = rest % nN, pm = 32 + rest / nN; const int snt = nt >> 3;
            u.kind = 1 + s; u.pm = pm; u.pn = pn; u.nt = snt; u.a = A + (size_t)pm * 256 * lda * 2 + (size_t)s * snt * 128; u.b = B + (size_t)pn * 256 * ldb * 2 + (size_t)s * snt * 128; }
        return true;
    }
};
struct SchedOne { Unit u; __device__ __forceinline__ bool next(int i, Unit& o) const { if (i) return false; o = u; return true; } };

struct EpiP2 {
    static constexpr bool PERM = true;
    unsigned char* ws; int layer;
    __device__ __forceinline__ void operator()(const f32x4 (&acc)[2][2][4][2], const Unit& u, int wr, int wc, int fr, int fq) const {
        if (u.kind == K_TFOLD || u.kind == K_TV) {
#pragma unroll
            for (int ai = 0; ai < 2; ++ai)
#pragma unroll
                for (int m = 0; m < 4; ++m) {
                    const int rr = 128 * ai + 64 * wr + 16 * m + fr;
#pragma unroll
                    for (int bj = 0; bj < 2; ++bj) {
                        const int tok = 256 * u.pn + 128 * bj + 32 * wc + 8 * fq;
                        const f32x4 v0 = acc[ai][bj][m][0], v1 = acc[ai][bj][m][1];
                        u32x4 w; w.x = pk2(v0[0], v0[1]); w.y = pk2(v0[2], v0[3]); w.z = pk2(v1[0], v1[1]); w.w = pk2(v1[2], v1[3]);
                        const bool lat = tok < NLAT; const int t2 = tok - NLAT;
                        const int b = lat ? (tok >> 11) : (t2 >> 8), pos = lat ? (tok & 2047) : (t2 & 255);
                        bf16_t* dst;
                        if (u.kind == K_TFOLD) { const int g = u.pm, cs = rr >> 7, e = rr & 127;
                            dst = lat ? (bf16_t*)(ws + O_ABT) + (size_t)(g * 128 + e) * 16384 + b * 4096 + cs * 2048 + pos
                                      : (bf16_t*)(ws + O_ABTC) + (size_t)(g * 128 + e) * 2048 + b * 512 + cs * 256 + pos; }
                        else { const int n2 = 256 * (u.pm - 4) + rr, h = n2 >> 7, e = n2 & 127;
                            dst = (bf16_t*)(ws + O_VT) + ((size_t)(b * NH + h) * 128 + e) * LK + (lat ? 256 + pos : pos); }
                        *(u32x4*)dst = w;
                    }
                }
        } else {
            const float* rope = (const float*)(ws + O_ROPE);
            float kmx0 = 0.f, kmx1 = 0.f;
            const int pnl = u.pn & 3;
            if (u.kind == K_NGLU) {
#pragma unroll
                for (int ai = 0; ai < 2; ++ai)
#pragma unroll
                    for (int m = 0; m < 4; ++m) {
                        const int tok = 256 * u.pm + 128 * ai + 64 * wr + 16 * m + fr;
#pragma unroll
                        for (int bj = 0; bj < 2; ++bj) {
                            const f32x4 v0 = acc[ai][bj][m][0], v1 = acc[ai][bj][m][1];
                            const int cl = 256 * pnl + 128 * bj + 32 * wc + 8 * fq;
                            u32x2 w; w.x = pk2(v0[0] * fsigmoid(v1[0]), v0[1] * fsigmoid(v1[1])); w.y = pk2(v0[2] * fsigmoid(v1[2]), v0[3] * fsigmoid(v1[3]));
                            *(u32x2*)((bf16_t*)(ws + O_Z) + (size_t)tok * 512 + (cl >> 1)) = w;
                        }
                    }
            } else {
                const int d1 = ((wc & 1) * 4 + fq) * 4;
                f32x4 rc[2][4], rs[2][4];
#pragma unroll
                for (int ai = 0; ai < 2; ++ai)
#pragma unroll
                    for (int m = 0; m < 4; ++m) { const int tok = 256 * u.pm + 128 * ai + 64 * wr + 16 * m + fr;
                        const float* rp = rope + (size_t)(tok < NLAT ? (tok & 2047) : 0) * 64 + d1;
                        rc[ai][m] = *(const f32x4*)rp; rs[ai][m] = *(const f32x4*)(rp + 32); }
#pragma unroll
                for (int ai = 0; ai < 2; ++ai)
#pragma unroll
                    for (int m = 0; m < 4; ++m) {
                        const int tok = 256 * u.pm + 128 * ai + 64 * wr + 16 * m + fr;
                        const bool lat = tok < NLAT; const int t2 = tok - NLAT;
                        const int b = lat ? (tok >> 11) : (t2 >> 8), pos = lat ? (tok & 2047) : (t2 & 255);
                        const f32x4 cs = lat ? rc[ai][m] : (f32x4){1.f, 1.f, 1.f, 1.f}, sn = lat ? rs[ai][m] : (f32x4){0.f, 0.f, 0.f, 0.f};
#pragma unroll
                        for (int bj = 0; bj < 2; ++bj) {
                            const f32x4 v0 = acc[ai][bj][m][0], v1 = acc[ai][bj][m][1];
                            const int blk = 4 * pnl + 2 * bj + (wc >> 1);
                            f32x4 o1 = v0 * cs - v1 * sn, o2 = v1 * cs + v0 * sn;
                            if (u.kind == K_NQ) { o1 = o1 * QSCALE; o2 = o2 * QSCALE;
                                bf16_t* dst = (bf16_t*)(ws + O_Q) + (size_t)tok * 1024 + blk * 64 + d1;
                                u32x2 w1, w2; w1.x = pk2(o1[0], o1[1]); w1.y = pk2(o1[2], o1[3]); w2.x = pk2(o2[0], o2[1]); w2.y = pk2(o2[2], o2[3]);
                                *(u32x2*)dst = w1; *(u32x2*)(dst + 32) = w2;
                            } else {
                                const int key = lat ? 256 + pos : pos;
                                { float ps = (o1[0] * o1[0] + o1[1] * o1[1]) + (o1[2] * o1[2] + o1[3] * o1[3]) + (o2[0] * o2[0] + o2[1] * o2[1]) + (o2[2] * o2[2] + o2[3] * o2[3]);
                                  ps += __shfl_xor(ps, 16); ps += __shfl_xor(ps, 32);
                                  if (bj == 0) kmx0 = fmaxf(kmx0, ps); else kmx1 = fmaxf(kmx1, ps); }
                                bf16_t* dst = (bf16_t*)(ws + O_KK) + ((size_t)(b * 16 + blk) * LK + key) * 64 + d1;
                                u32x2 w1, w2; w1.x = pk2(o1[0], o1[1]); w1.y = pk2(o1[2], o1[3]); w2.x = pk2(o2[0], o2[1]); w2.y = pk2(o2[2], o2[3]);
                                *(u32x2*)dst = w1; *(u32x2*)(dst + 32) = w2;
                            }
                        }
                    }
            }
            if (u.kind == K_NK) {
#pragma unroll
                for (int o = 1; o < 16; o <<= 1) { kmx0 = fmaxf(kmx0, __shfl_xor(kmx0, o)); kmx1 = fmaxf(kmx1, __shfl_xor(kmx1, o)); }
                const int tok0 = 256 * u.pm; const int b = tok0 < NLAT ? (tok0 >> 11) : ((tok0 - NLAT) >> 8);
                const int blk0 = 4 * (u.pn & 3) + (wc >> 1);
                if (fr == 0 && fq == 0) { unsigned* km = (unsigned*)(ws + O_KMAX) + layer * 64 + b * 16 + blk0;
                    atomicMax(km, __float_as_uint(2.0f * kmx0)); atomicMax(km + 2, __float_as_uint(2.0f * kmx1)); }
            }
        }
    }
};
struct EpiY {
    static constexpr bool PERM = true;
    bf16_t* Y; bf16_t* YP; size_t split_stride;
    __device__ __forceinline__ void operator()(const f32x4 (&acc)[2][2][4][2], const Unit& u, int wr, int wc, int fr, int fq) const {
        const int row0 = wr * 64 + fr, col0 = u.pn * 256 + wc * 32 + 8 * fq;
        bf16_t* base = u.kind == 0 ? Y + (size_t)u.pm * 256 * D : YP + (size_t)(u.kind - 1) * split_stride + (size_t)(u.pm - 32) * 256 * D;
#pragma unroll
        for (int ai = 0; ai < 2; ++ai)
#pragma unroll
            for (int m = 0; m < 4; ++m) { bf16_t* rowp = base + (size_t)(row0 + ai * 128 + m * 16) * D + col0;
#pragma unroll
                for (int bj = 0; bj < 2; ++bj) { const f32x4 v0 = acc[ai][bj][m][0], v1 = acc[ai][bj][m][1];
                    u32x4 w; w.x = pk2(v0[0], v0[1]); w.y = pk2(v0[2], v0[3]); w.z = pk2(v1[0], v1[1]); w.w = pk2(v1[2], v1[3]);
                    *(u32x4*)(rowp + bj * 128) = w; } }
    }
};

template <int ACT  > struct EpiBf16 {
    static constexpr bool PERM = true;
    bf16_t* O; int ldc;
    __device__ __forceinline__ void operator()(const f32x4 (&acc)[2][2][4][2], const Unit& u, int wr, int wc, int fr, int fq) const {
        const int row0 = u.pm * 256 + wr * 64 + fr, col0 = u.pn * 256 + wc * 32 + 8 * fq;
#pragma unroll
        for (int ai = 0; ai < 2; ++ai)
#pragma unroll
            for (int m = 0; m < 4; ++m) { bf16_t* rowp = O + (size_t)(row0 + ai * 128 + m * 16) * ldc + col0;
#pragma unroll
                for (int bj = 0; bj < 2; ++bj) { f32x4 v0 = acc[ai][bj][m][0], v1 = acc[ai][bj][m][1];
                    if (ACT == 1) {
#pragma unroll
                        for (int j = 0; j < 4; ++j) { const float a = fmaxf(v0[j], 0.f), b = fmaxf(v1[j], 0.f); v0[j] = a * a; v1[j] = b * b; } }
                    u32x4 w; w.x = pk2(v0[0], v0[1]); w.y = pk2(v0[2], v0[3]); w.z = pk2(v1[0], v1[1]); w.w = pk2(v1[2], v1[3]);
                    *(u32x4*)(rowp + bj * 128) = w; } }
    }
};

template <class RowMap>
__device__ __forceinline__ void tr_tile(const float* src, int ldn, int k0, int n0, bf16_t* dst, int ldk, int kdst0, const RowMap& rm, LAS float* scr) {
    const int tid = opaque_tid();
    f32x4 v[8];
#pragma unroll
    for (int i = 0; i < 8; ++i) { const int idx = tid + 512 * i, kk = idx >> 4, c = (idx & 15) * 4; v[i] = *(const f32x4*)(src + (size_t)(k0 + kk) * ldn + n0 + c); }
#pragma unroll
    for (int i = 0; i < 8; ++i) { const int idx = tid + 512 * i, kk = idx >> 4, c = (idx & 15) * 4;
        scr[kk * 65 + c] = v[i][0]; scr[kk * 65 + c + 1] = v[i][1]; scr[kk * 65 + c + 2] = v[i][2]; scr[kk * 65 + c + 3] = v[i][3]; }
    __syncthreads();
    { const int n = tid >> 3, kc = tid & 7; bf16_t* drow = dst + (size_t)rm(n0 + n) * ldk + kdst0 + kc * 8;
        float tv[4][8];
#pragma unroll
        for (int hf = 0; hf < 4; ++hf) { const LAS float* s = scr + (hf * 64 + kc * 8) * 65 + n;
#pragma unroll
            for (int j = 0; j < 8; ++j) tv[hf][j] = s[j * 65]; }
#pragma unroll
        for (int hf = 0; hf < 4; ++hf) {
            u32x4 o; o.x = pk2(tv[hf][0], tv[hf][1]); o.y = pk2(tv[hf][2], tv[hf][3]); o.z = pk2(tv[hf][4], tv[hf][5]); o.w = pk2(tv[hf][6], tv[hf][7]);
            *(u32x4*)(drow + hf * 64) = o; } }
    __syncthreads();
}
struct RmId { __device__ __forceinline__ int operator()(int n) const { return n; } };
struct RmWin {
    __device__ __forceinline__ int operator()(int n) const {
        if (n < 1536) { const int x = n - 512, ch = x & 511, gate = x >> 9; return 2048 + (ch >> 2) * 8 + gate * 4 + (ch & 3); }
        if (n < 3584) { const int x = n - 1536, blk = x >> 6, d = x & 63; return 3072 + blk * 64 + ((d & 31) >> 2) * 8 + (d >> 5) * 4 + (d & 3); }
        return 1024 + (n - 3584);
    }
};

__device__ __forceinline__ void phase_prep(const Params& p, LAS unsigned char* lds) {
    const int tid = opaque_tid(), G = gridDim.x;
    unsigned char* ws = p.ws;
    LAS float* scr = (LAS float*)lds;
    constexpr int I_ADA = 768, I_TRL = 512 + 256 + 1024 + 1024, I_TR = 2 * I_TRL;
    constexpr int I_WINF = 640, I_WPW = 128, I_DFT = 0, I_DFTC = 32, I_ROPE = 16, I_MT = 128, I_BO = 32, I_MISC = 1;
    constexpr int NIT = I_ADA + I_TR + I_WINF + I_WPW + I_DFT + I_DFTC + I_ROPE + I_MT + I_BO + I_MISC;
    bool sc_ready = false;
    for (int it = blockIdx.x; it < NIT; it += G) {
        int r = it < I_MT + I_BO + I_MISC ? NIT - (I_MT + I_BO + I_MISC) + it : it - (I_MT + I_BO + I_MISC);
        if (r < I_ADA) {
            const int l = r / 384, n0 = (r % 384) * 32;
            LAS float* sc = scr;
            if (!sc_ready) { for (int i = tid; i < 5 * 2048; i += NTHR) { const int bi = i >> 11, k = i & 2047; const float v = bi < 4 ? p.c[bi * 2048 + k] : p.c_ctx[k]; sc[i] = v * fsigmoid(v); } sc_ready = true; }
            __syncthreads();
            const int kg = tid >> 3, c4 = (tid & 7) * 4;
            f32x4 a[5];
#pragma unroll
            for (int bi = 0; bi < 5; ++bi) a[bi] = (f32x4){0.f, 0.f, 0.f, 0.f};
            const float* W = p.w_ada + (size_t)l * 2048 * 12288 + n0 + c4;
#pragma unroll 1
            for (int i0 = 0; i0 < 32; i0 += 8) {
                f32x4 w[8];
#pragma unroll
                for (int u = 0; u < 8; ++u) w[u] = *(const f32x4*)(W + (size_t)(kg + 64 * (i0 + u)) * 12288);
#pragma unroll
                for (int u = 0; u < 8; ++u) { const int k = kg + 64 * (i0 + u);
#pragma unroll
                    for (int bi = 0; bi < 5; ++bi) a[bi] += w[u] * sc[bi * 2048 + k]; } }
            LAS float* red = scr + 5 * 2048;
#pragma unroll
            for (int bi = 0; bi < 5; ++bi)
#pragma unroll
                for (int j = 0; j < 4; ++j) red[(kg * 8 + (tid & 7)) * 20 + bi * 4 + j] = a[bi][j];
            __syncthreads();
            if (tid < 160) { const int cl = tid / 20, q = tid % 20; float s = 0.f; for (int g = 0; g < 64; ++g) s += red[(g * 8 + cl) * 20 + q];
                const int bi = q >> 2, j = q & 3, n = n0 + cl * 4 + j;
                ((float*)(ws + O_MOD))[(size_t)(l * 5 + bi) * 12288 + n] = s + p.b_ada[l * 12288 + n]; }
            __syncthreads();
            continue;
        }
        r -= I_ADA; sc_ready = false;
        if (r < I_TR) {
            const int l = r / I_TRL; int q = r % I_TRL;
            if (l == 1 && (q < 512 || q >= 768)) continue;
            if (q < 512) { const int kt = q >> 6, ntile = q & 63; tr_tile(p.w_in + (size_t)l * 2048 * INC, INC, kt * 256, 512 + ntile * 64, (bf16_t*)(ws + O_WINT + l * SZ_WINT), 2048, kt * 256, RmWin(), scr); continue; }
            q -= 512;
            if (q < 256) { const int kt = q >> 5, ntile = q & 31; const int k0 = kt * 256;
                if (k0 >= 512 && k0 < 1024) tr_tile(p.w_out + (size_t)l * 2048 * 2048, 2048, k0, ntile * 64, (bf16_t*)(ws + O_WTMP + l * SZ_WTMP), 512, k0 - 512, RmId(), scr);
                else tr_tile(p.w_out + (size_t)l * 2048 * 2048, 2048, k0, ntile * 64, (bf16_t*)(ws + O_WOUTF + l * SZ_WOUTF), 2048, k0, RmId(), scr);
                continue; }
            q -= 256;
            if (q < 1024) { const int kt = q >> 7, ntile = q & 127; tr_tile(p.w_mlp_in + (size_t)l * 2048 * 8192, 8192, kt * 256, ntile * 64, (bf16_t*)(ws + O_WMI + l * SZ_WMI), 2048, kt * 256, RmId(), scr); continue; }
            q -= 1024;
            { const int kt = q >> 5, ntile = q & 31; tr_tile(p.w_mlp_out + (size_t)l * 8192 * 2048, 2048, kt * 256, ntile * 64, (bf16_t*)(ws + O_WMO + l * SZ_WMO), 8192, kt * 256, RmId(), scr); continue; }
        }
        r -= I_TR;
        if (r < I_WINF) {
            const size_t e0 = (size_t)r * 4096 + (size_t)tid * 8; const int l = (int)(e0 / (2048 * 640)); const size_t x = e0 % (2048 * 640); const int k = (int)(x / 640), c = (int)(x % 640);
            u32x4 o = (u32x4){0u, 0u, 0u, 0u};
            if (c < 512) { const float* s = p.w_in + ((size_t)l * 2048 + k) * INC + c; const f32x4 a = *(const f32x4*)s, b = *(const f32x4*)(s + 4);
                o.x = pk2(a[0], a[1]); o.y = pk2(a[2], a[3]); o.z = pk2(b[0], b[1]); o.w = pk2(b[2], b[3]); }
            *(u32x4*)((bf16_t*)(ws + O_WINF) + e0) = o; continue;
        }
        r -= I_WINF;
        if (r < I_WPW) { const size_t e0 = (size_t)r * 4096 + (size_t)tid * 8; const float* s = p.w_conv_pw + e0; const f32x4 a = *(const f32x4*)s, b = *(const f32x4*)(s + 4);
            u32x4 o; o.x = pk2(a[0], a[1]); o.y = pk2(a[2], a[3]); o.z = pk2(b[0], b[1]); o.w = pk2(b[2], b[3]); *(u32x4*)((bf16_t*)(ws + O_WPW) + e0) = o; continue; }
        r -= I_WPW;
        if (r < I_DFT) {
            const size_t e0 = (size_t)r * 4096 + (size_t)tid * 8; const int j = (int)(e0 >> 12), k0 = (int)(e0 & 4095);
            float v[8];
#pragma unroll
            for (int i = 0; i < 8; ++i) { const int k = k0 + i, kk = k & 2047; const float rev = (float)((j * kk) & 2047) * (1.0f / 2048.0f);
                v[i] = (k < 2048 ? cos_rev(rev) : -sin_rev(rev)) * 0.02209708691207961f; }
            u32x4 o; o.x = pk2(v[0], v[1]); o.y = pk2(v[2], v[3]); o.z = pk2(v[4], v[5]); o.w = pk2(v[6], v[7]); *(u32x4*)((bf16_t*)(ws + O_DFT) + e0) = o; continue;
        }
        r -= I_DFT;
        if (r < I_DFTC) {
            const size_t e0 = (size_t)r * 4096 + (size_t)tid * 8; const int j = (int)(e0 >> 9), k0 = (int)(e0 & 511);
            float v[8];
#pragma unroll
            for (int i = 0; i < 8; ++i) { const int k = k0 + i, kk = k & 255; const float rev = (float)((j * kk) & 255) * (1.0f / 256.0f);
                v[i] = (k < 256 ? cos_rev(rev) : -sin_rev(rev)) * 0.0625f; }
            u32x4 o; o.x = pk2(v[0], v[1]); o.y = pk2(v[2], v[3]); o.z = pk2(v[4], v[5]); o.w = pk2(v[6], v[7]); *(u32x4*)((bf16_t*)(ws + O_DFTC) + e0) = o; continue;
        }
        r -= I_DFTC;
        if (r < I_ROPE) {
#pragma unroll
            for (int i = 0; i < 8; ++i) { const int e = r * 4096 + i * 512 + tid, pos = e >> 5, f = e & 31;
                const float inv = exp2f(-(float)(f & 15) * (13.287712379549449f / 16.0f));
                const float ang = (float)(f < 16 ? (pos >> 6) : (pos & 63)) * inv;
                float rev = ang * 0.15915494309189535f; rev -= floorf(rev);
                float* o = (float*)(ws + O_ROPE) + (size_t)pos * 64 + f; o[0] = cos_rev(rev); o[32] = sin_rev(rev); }
            continue;
        }
        r -= I_ROPE;
        if (r < I_MT) {
            const int l = r >> 6, g = (r >> 4) & 3, cs = (r >> 3) & 1, cq = r & 7;
            const float* Wf = p.w_fourier + (size_t)(l * 4 + g) * 128 * 128;
            LAS float* sw = scr;
            LAS float* tb = scr + 128 * 128;
            for (int i = tid; i < 128 * 128; i += NTHR) sw[i] = Wf[i];
            if (tid < 128) { const float rev = (float)tid * (1.0f / 128.0f); tb[tid] = (cs ? sin_rev(rev) : cos_rev(rev)) * 0.08838834764831845f; }
            __syncthreads();
            bf16_t* dst = (bf16_t*)(ws + O_MTP + l * SZ_MTP) + (size_t)(g * 256 + cs * 128) * 256;
            for (int o = tid; o < 16 * 128; o += NTHR) { const int e = o & 127, c = cq * 16 + (o >> 7); float s = 0.f;
#pragma unroll 8
                for (int c2 = 0; c2 < 128; ++c2) s += tb[(c * c2) & 127] * sw[c2 * 128 + e];
                dst[(size_t)e * 256 + c] = (bf16_t)(pk2(s, 0.f) & 0xffffu); dst[(size_t)e * 256 + 128 + c] = 0; }
            __syncthreads();
            continue;
        }
        r -= I_MT;
        if (r < I_BO) {
            const int l = r >> 4, n = (r & 15) * 128 + (tid & 127), jq = tid >> 7;
            const float* W = p.w_out + ((size_t)l * 2048 + 512 + jq * 128) * 2048 + n; const float* bp = p.b_conv_pw + l * 512 + jq * 128;
            float s = 0.f;
#pragma unroll 1
            for (int j0 = 0; j0 < 128; j0 += 16) { float w[16];
#pragma unroll
                for (int u = 0; u < 16; ++u) w[u] = W[(size_t)(j0 + u) * 2048];
#pragma unroll
                for (int u = 0; u < 16; ++u) s += bp[j0 + u] * w[u]; }
            scr[tid] = s;
            __syncthreads();
            if (tid < 128) ((float*)(ws + O_BO))[l * 2048 + n] = (scr[tid] + scr[tid + 128]) + (scr[tid + 256] + scr[tid + 384]);
            __syncthreads();
            continue;
        }
        r -= I_BO;
        {
            if (tid < 128) { const int l = tid >> 6, i = tid & 63; const float a = wave_sum(p.lq1[l * 64 + i] * p.lk1[l * 64 + i]), b = wave_sum(p.lq2[l * 64 + i] * p.lk2[l * 64 + i]);
                if (i == 0) ((float*)(ws + O_MISC))[l] = __expf(a) - __expf(b) + (0.8f - 0.6f * __expf(-0.3f * (float)l)); }
            if (tid >= 128 && tid < 144) ((unsigned*)(ws + O_MISC))[16 + (tid - 128) * 8] = 0u;
            if (tid >= 256 && tid < 384) ((unsigned*)(ws + O_KMAX))[tid - 256] = 0u;
        }
    }
}

struct RowArgs {
    int mode; bool hasH; int nrows;
    const float* xlat; const float* xctx; float* olat; float* octx;
    const bf16_t* Y; const bf16_t* YP; const float* bias;
    const float* gpost; const float* gn; const float* mod;
    const float* modn; int gate_off, sh_off, sc_off; bf16_t* H;
    const bf16_t* x16; bf16_t* o16; bool in16, out16;
};
__device__ __forceinline__ void phase_rows(const RowArgs& a) {
    const int tid = opaque_tid(), lane = tid & 63, wid = tid >> 6, gw = blockIdx.x * 8 + wid, NW = gridDim.x * 8;
    for (int r = gw; r < a.nrows; r += NW) {
        const bool lat = r < NLAT; const int bi = lat ? (r >> 11) : 4;
        int l4 = lane * 4; asm volatile("" : "+v"(l4));
        const float* xr = (lat ? a.xlat + (size_t)r * D : a.xctx + (size_t)(r - NLAT) * D) + l4;
        f32x4 x[8];
        if (a.in16) { u32x2 w[8];
#pragma unroll
            for (int j = 0; j < 8; ++j) w[j] = *(const u32x2*)(a.x16 + (size_t)r * D + l4 + 256 * j);
#pragma unroll
            for (int j = 0; j < 8; ++j) x[j] = (f32x4){bf_lo(w[j].x), bf_hi(w[j].x), bf_lo(w[j].y), bf_hi(w[j].y)};
        } else {
#pragma unroll
            for (int j = 0; j < 8; ++j) x[j] = *(const f32x4*)(xr + 256 * j);
        }
        if (a.mode == 1) {
            f32x4 y[8];
            if (lat) {
                u32x2 w[8];
#pragma unroll
                for (int j = 0; j < 8; ++j) w[j] = *(const u32x2*)(a.Y + (size_t)r * D + l4 + 256 * j);
#pragma unroll
                for (int j = 0; j < 8; ++j) y[j] = (f32x4){bf_lo(w[j].x), bf_hi(w[j].x), bf_lo(w[j].y), bf_hi(w[j].y)};
            } else {
#pragma unroll
                for (int j = 0; j < 8; ++j) y[j] = (f32x4){0.f, 0.f, 0.f, 0.f};
#pragma unroll 1
                for (int q = 0; q < 8; q += 4) { const bf16_t* yp = a.YP + (size_t)q * NCTX * D + (size_t)(r - NLAT) * D + l4;
                    u32x2 t[4][8];
#pragma unroll
                    for (int qq = 0; qq < 4; ++qq)
#pragma unroll
                        for (int j = 0; j < 8; ++j) t[qq][j] = *(const u32x2*)(yp + (size_t)qq * NCTX * D + 256 * j);
#pragma unroll
                    for (int qq = 0; qq < 4; ++qq)
#pragma unroll
                        for (int j = 0; j < 8; ++j) y[j] += (f32x4){bf_lo(t[qq][j].x), bf_hi(t[qq][j].x), bf_lo(t[qq][j].y), bf_hi(t[qq][j].y)}; }
            }
            if (a.bias) {
                f32x4 bv[8];
#pragma unroll
                for (int j = 0; j < 8; ++j) bv[j] = *(const f32x4*)(a.bias + l4 + 256 * j);
#pragma unroll
                for (int j = 0; j < 8; ++j) y[j] += bv[j]; }
            const float* gate = a.mod + (size_t)bi * 12288 + a.gate_off + l4;
            f32x4 g[8], gp[8];
#pragma unroll
            for (int j = 0; j < 8; ++j) { g[j] = *(const f32x4*)(gate + 256 * j); gp[j] = *(const f32x4*)(a.gpost + l4 + 256 * j); }
            float ss = 0.f;
#pragma unroll
            for (int j = 0; j < 8; ++j) ss += (y[j][0] * y[j][0] + y[j][1] * y[j][1]) + (y[j][2] * y[j][2] + y[j][3] * y[j][3]);
            const float rstd = rsqrtf(wave_sum(ss) * (1.0f / D) + EPS);
#pragma unroll
            for (int j = 0; j < 8; ++j) x[j] = x[j] + g[j] * (y[j] * rstd * gp[j]);
        }
        if (a.hasH) {
            const float* sh = a.modn + (size_t)bi * 12288 + a.sh_off + l4; const float* sc = a.modn + (size_t)bi * 12288 + a.sc_off + l4;
            f32x4 gn[8], s1[8], s2[8];
#pragma unroll
            for (int j = 0; j < 8; ++j) { gn[j] = *(const f32x4*)(a.gn + l4 + 256 * j); s1[j] = *(const f32x4*)(sh + 256 * j); s2[j] = *(const f32x4*)(sc + 256 * j); }
            float ss = 0.f;
#pragma unroll
            for (int j = 0; j < 8; ++j) ss += (x[j][0] * x[j][0] + x[j][1] * x[j][1]) + (x[j][2] * x[j][2] + x[j][3] * x[j][3]);
            const float rstd = rsqrtf(wave_sum(ss) * (1.0f / D) + EPS);
            u32x2 w[8];
#pragma unroll
            for (int j = 0; j < 8; ++j) { const f32x4 h = (x[j] * rstd * gn[j]) * (s2[j] + 1.0f) + s1[j]; w[j].x = pk2(h[0], h[1]); w[j].y = pk2(h[2], h[3]); }
#pragma unroll
            for (int j = 0; j < 8; ++j) *(u32x2*)(a.H + (size_t)r * D + l4 + 256 * j) = w[j];
        }
        if (a.mode == 1) {
            if (a.out16) {
#pragma unroll
                for (int j = 0; j < 8; ++j) { u32x2 w; w.x = pk2(x[j][0], x[j][1]); w.y = pk2(x[j][2], x[j][3]); *(u32x2*)(a.o16 + (size_t)r * D + l4 + 256 * j) = w; }
            } else {
                float* orow = (lat ? a.olat + (size_t)r * D : a.octx + (size_t)(r - NLAT) * D) + l4;
#pragma unroll
                for (int j = 0; j < 8; ++j) *(f32x4*)(orow + 256 * j) = x[j];
            }
        }
    }
}

__device__ __forceinline__ void attn_item(const Params& p, LAS unsigned char* lds, int l, int b, int h, int qb, bool isctx) {
    unsigned char* ws = p.ws;
    const int tid = opaque_tid(), wid = __builtin_amdgcn_readfirstlane(tid >> 6), lane = tid & 63, mm = wid >> 2, rg = wid & 3, qi = lane & 31, hh = lane >> 5;
    const int nt = isctx ? 4 : 36;
    const int qrow = (isctx ? NLAT + b * 256 : b * 2048) + qb * 128 + rg * 32 + qi;
    bf16x8 Bq[4];
    { const bf16_t* Q = (const bf16_t*)(ws + O_Q) + (size_t)qrow * 1024 + h * 128 + mm * 64 + hh * 8;
#pragma unroll
        for (int ks = 0; ks < 4; ++ks) Bq[ks] = *(const bf16x8*)(Q + ks * 16); }
    const char* Kb = (const char*)(ws + O_KK) + (size_t)((b * NH + h) * 2) * LK * 128;
    const char* Vb = (const char*)(ws + O_VT) + (size_t)(b * NH + h) * 128 * LK * 2;
    const int skey = tid >> 3, sch = tid & 7;
    const unsigned koff = (unsigned)(skey * 128 + sch * 16);
    const char* Kb1 = Kb + (size_t)LK * 128;
    const int kdst = skey * 128 + ((sch ^ ((skey >> 1) & 7)) * 16);
    const int e0s = skey, e1s = skey + 64;
    const unsigned voff = (unsigned)(e0s * (LK * 2) + sch * 16); const char* Vb1 = Vb + (size_t)64 * (LK * 2);
    const int vsw = (skey >> 1) & 7;
    const int vdA = (((sch & 6)) ^ vsw) * 16 + (sch & 1) * 8, vdB = (((sch & 6) + 1) ^ vsw) * 16 + (sch & 1) * 8;
    const int vdst0 = e0s * 128, vdst1 = e1s * 128;
    u32x4 rk0, rk1, rv0, rv1;
#define ATT_LOAD(t) do { rk0 = *(const u32x4*)(Kb + (koff + (unsigned)(t) * 8192u)); rk1 = *(const u32x4*)(Kb1 + (koff + (unsigned)(t) * 8192u)); \
        rv0 = *(const u32x4*)(Vb + (voff + (unsigned)(t) * 128u)); rv1 = *(const u32x4*)(Vb1 + (voff + (unsigned)(t) * 128u)); } while (0)
#define ATT_STORE(buf) do { *(LAS u32x4*)(lds + (buf) * 16384 + kdst) = rk0; *(LAS u32x4*)(lds + (buf) * 16384 + 8192 + kdst) = rk1; \
        *(LAS u32x2*)(lds + 32768 + (buf) * 16384 + vdst0 + vdA) = (u32x2){rv0.x, rv0.y}; *(LAS u32x2*)(lds + 32768 + (buf) * 16384 + vdst0 + vdB) = (u32x2){rv0.z, rv0.w}; \
        *(LAS u32x2*)(lds + 32768 + (buf) * 16384 + vdst1 + vdA) = (u32x2){rv1.x, rv1.y}; *(LAS u32x2*)(lds + 32768 + (buf) * 16384 + vdst1 + vdB) = (u32x2){rv1.z, rv1.w}; } while (0)
    f32x16 oacc[4];
#pragma unroll
    for (int et = 0; et < 4; ++et)
#pragma unroll
        for (int r = 0; r < 16; ++r) oacc[et][r] = 0.f;
    float lsum = 0.f, nmref;
    { float qs = 0.f;
#pragma unroll
        for (int ks = 0; ks < 4; ++ks) { const u32x4 w = __builtin_bit_cast(u32x4, Bq[ks]);
#pragma unroll
            for (int j = 0; j < 4; ++j) { const float a = bf_lo(w[j]), c = bf_hi(w[j]); qs += a * a + c * c; } }
        qs += __shfl_xor(qs, 32);
        const float k2 = __uint_as_float(((const unsigned*)(ws + O_KMAX))[l * 64 + b * 16 + h * 2 + mm]);
        nmref = -(sqrtf(qs * k2) * 1.02f + 1e-6f); }
    const int ksw = (qi >> 1) & 7;
    const int kread = mm * 8192 + qi * 128;
    const int vread = 32768 + qi * 128;
    ATT_LOAD(0);
    const u32x4 rk2 = *(const u32x4*)(Kb + (koff + 8192u)), rk3 = *(const u32x4*)(Kb1 + (koff + 8192u));
    { *(LAS u32x4*)(lds + kdst) = rk0; *(LAS u32x4*)(lds + 8192 + kdst) = rk1;
      *(LAS u32x2*)(lds + 32768 + 16384 + vdst0 + vdA) = (u32x2){rv0.x, rv0.y}; *(LAS u32x2*)(lds + 32768 + 16384 + vdst0 + vdB) = (u32x2){rv0.z, rv0.w};
      *(LAS u32x2*)(lds + 32768 + 16384 + vdst1 + vdA) = (u32x2){rv1.x, rv1.y}; *(LAS u32x2*)(lds + 32768 + 16384 + vdst1 + vdB) = (u32x2){rv1.z, rv1.w}; }
    { *(LAS u32x4*)(lds + 16384 + kdst) = rk2; *(LAS u32x4*)(lds + 16384 + 8192 + kdst) = rk3; }
    __syncthreads();
    f32x16 s0, s1;
#pragma unroll
    for (int r = 0; r < 16; ++r) { s0[r] = nmref; s1[r] = nmref; }
#pragma unroll
    for (int ks = 0; ks < 4; ++ks) {
        const int co = ((2 * ks + hh) ^ ksw) * 16;
        const bf16x8 a0 = *(const LAS bf16x8*)(lds + kread + co);
        const bf16x8 a1 = *(const LAS bf16x8*)(lds + kread + 4096 + co);
        s0 = __builtin_amdgcn_mfma_f32_32x32x16_bf16(a0, Bq[ks], s0, 0, 0, 0);
        s1 = __builtin_amdgcn_mfma_f32_32x32x16_bf16(a1, Bq[ks], s1, 0, 0, 0);
    }
    bf16x8 Pf[4];
#pragma unroll
    for (int i = 0; i < 4; ++i) Pf[i] = (bf16x8){0, 0, 0, 0, 0, 0, 0, 0};
    for (int t = 0; t < nt; ++t) {
        const int bk = ((t + 1) & 1) * 16384, bv = ((t + 1) & 1) * 16384;
        rv0 = *(const u32x4*)(Vb + (voff + (unsigned)t * 128u)); rv1 = *(const u32x4*)(Vb1 + (voff + (unsigned)t * 128u));
        if (t + 2 < nt) { rk0 = *(const u32x4*)(Kb + (koff + (unsigned)(t + 2) * 8192u)); rk1 = *(const u32x4*)(Kb1 + (koff + (unsigned)(t + 2) * 8192u)); }
#pragma unroll
        for (int s4 = 0; s4 < 4; ++s4) {
            const int c0 = ((2 * s4 + hh) ^ ksw) * 16;
#pragma unroll
            for (int et = 0; et < 4; ++et) {
                const bf16x8 vv = *(const LAS bf16x8*)(lds + bv + vread + et * 4096 + c0);
                oacc[et] = __builtin_amdgcn_mfma_f32_32x32x16_bf16(vv, Pf[s4], oacc[et], 0, 0, 0);
            }
        }
        f32x16 n0, n1;
#pragma unroll
        for (int r = 0; r < 16; ++r) { n0[r] = nmref; n1[r] = nmref; }
#pragma unroll
        for (int ks = 0; ks < 4; ++ks) {
            const int co = ((2 * ks + hh) ^ ksw) * 16;
            const bf16x8 a0 = *(const LAS bf16x8*)(lds + bk + kread + co);
            const bf16x8 a1 = *(const LAS bf16x8*)(lds + bk + kread + 4096 + co);
            n0 = __builtin_amdgcn_mfma_f32_32x32x16_bf16(a0, Bq[ks], n0, 0, 0, 0);
            n1 = __builtin_amdgcn_mfma_f32_32x32x16_bf16(a1, Bq[ks], n1, 0, 0, 0);
        }
        float ps = 0.f;
#pragma unroll
        for (int r = 0; r < 16; ++r) { s0[r] = __builtin_amdgcn_exp2f(s0[r]); s1[r] = __builtin_amdgcn_exp2f(s1[r]); ps += s0[r] + s1[r]; }
        lsum += ps;
        bf16x8 Pn[4];
#pragma unroll
        for (int s = 0; s < 2; ++s) {
            u32x4 w0, w1;
            w0.x = pk2(s0[8 * s + 0], s0[8 * s + 1]); w0.y = pk2(s0[8 * s + 2], s0[8 * s + 3]); w0.z = pk2(s0[8 * s + 4], s0[8 * s + 5]); w0.w = pk2(s0[8 * s + 6], s0[8 * s + 7]);
            w1.x = pk2(s1[8 * s + 0], s1[8 * s + 1]); w1.y = pk2(s1[8 * s + 2], s1[8 * s + 3]); w1.z = pk2(s1[8 * s + 4], s1[8 * s + 5]); w1.w = pk2(s1[8 * s + 6], s1[8 * s + 7]);
            Pn[s] = __builtin_bit_cast(bf16x8, w0); Pn[2 + s] = __builtin_bit_cast(bf16x8, w1);
        }
#pragma unroll
        for (int i = 0; i < 4; ++i) Pf[i] = Pn[i];
        s0 = n0; s1 = n1;
#pragma unroll
        for (int i = 0; i < 24; ++i) { __builtin_amdgcn_sched_group_barrier(0x008, 1, 0); __builtin_amdgcn_sched_group_barrier(0x002, 7, 0); }
        { const int bo = (t & 1) * 16384;
          *(LAS u32x2*)(lds + 32768 + bo + vdst0 + vdA) = (u32x2){rv0.x, rv0.y}; *(LAS u32x2*)(lds + 32768 + bo + vdst0 + vdB) = (u32x2){rv0.z, rv0.w};
          *(LAS u32x2*)(lds + 32768 + bo + vdst1 + vdA) = (u32x2){rv1.x, rv1.y}; *(LAS u32x2*)(lds + 32768 + bo + vdst1 + vdB) = (u32x2){rv1.z, rv1.w};
          if (t + 2 < nt) { *(LAS u32x4*)(lds + bo + kdst) = rk0; *(LAS u32x4*)(lds + bo + 8192 + kdst) = rk1; } }
        __syncthreads();
    }
    {
        const int bv = ((nt - 1) & 1) * 16384;
#pragma unroll
        for (int s4 = 0; s4 < 4; ++s4) {
            const int c0 = ((2 * s4 + hh) ^ ksw) * 16;
#pragma unroll
            for (int et = 0; et < 4; ++et) {
                const bf16x8 vv = *(const LAS bf16x8*)(lds + bv + vread + et * 4096 + c0);
                oacc[et] = __builtin_amdgcn_mfma_f32_32x32x16_bf16(vv, Pf[s4], oacc[et], 0, 0, 0);
            }
        }
    }
#undef ATT_LOAD
#undef ATT_STORE
    const float ltot = lsum + __shfl_xor(lsum, 32), inv = 1.0f / ltot;
    LAS float* comb = (LAS float*)(lds + 65536);
    if (mm == 1) {
#pragma unroll
        for (int et = 0; et < 4; ++et)
#pragma unroll
            for (int r = 0; r < 16; ++r) comb[(rg * 64 + et * 16 + r) * 64 + lane] = oacc[et][r] * inv;
    }
    __syncthreads();
    if (mm == 0) {
        const float lam = ((const float*)(ws + O_MISC))[l];
        const float post = 1.0f - (0.8f - 0.6f * __expf(-0.3f * (float)l));
        float ss = 0.f;
        float cv[4][16];
#pragma unroll
        for (int et = 0; et < 4; ++et)
#pragma unroll
            for (int r = 0; r < 16; ++r) cv[et][r] = comb[(rg * 64 + et * 16 + r) * 64 + lane];
#pragma unroll
        for (int et = 0; et < 4; ++et)
#pragma unroll
            for (int r = 0; r < 16; ++r) { const float o = oacc[et][r] * inv - lam * cv[et][r]; oacc[et][r] = o; ss += o * o; }
        ss += __shfl_xor(ss, 32);
        const float rstd = rsqrtf(ss * (1.0f / 128.0f) + EPS) * post;
        const float* gs = p.g_subln + l * 128;
        bf16_t* dst = (bf16_t*)(ws + O_CAT) + (size_t)qrow * D + 1024 + h * 128;
        f32x4 g[4][4];
#pragma unroll
        for (int et = 0; et < 4; ++et)
#pragma unroll
            for (int rq = 0; rq < 4; ++rq) g[et][rq] = *(const f32x4*)(gs + 32 * et + 8 * rq + 4 * hh);
        u32x2 w[4][4];
#pragma unroll
        for (int et = 0; et < 4; ++et)
#pragma unroll
            for (int rq = 0; rq < 4; ++rq) { w[et][rq].x = pk2(oacc[et][4 * rq] * rstd * g[et][rq][0], oacc[et][4 * rq + 1] * rstd * g[et][rq][1]);
                w[et][rq].y = pk2(oacc[et][4 * rq + 2] * rstd * g[et][rq][2], oacc[et][4 * rq + 3] * rstd * g[et][rq][3]); }
#pragma unroll
        for (int et = 0; et < 4; ++et)
#pragma unroll
            for (int rq = 0; rq < 4; ++rq) *(u32x2*)(dst + 32 * et + 8 * rq + 4 * hh) = w[et][rq];
    }
    __syncthreads();
}

__device__ __forceinline__ void conv_item(const Params& p, LAS unsigned char* lds, int l, int seq, int tile) {
    unsigned char* ws = p.ws;
    const int tid = opaque_tid(), wid = tid >> 6, lane = tid & 63;
    const bool lat = seq < 4; const int L = lat ? SEQ : CTXL; const int row0 = lat ? seq * SEQ : NLAT + (seq - 4) * CTXL; const int pos0 = tile * 32;
    LAS unsigned* zs = (LAS unsigned*)lds;
    LAS float* co = (LAS float*)(lds + 63488);
    const unsigned* Z = (const unsigned*)(ws + O_Z);
    for (int i = tid; i < 62 * 64; i += NTHR) { const int rr = i >> 6, c4 = (i & 63) * 4; const int pos = pos0 - 15 + rr;
        u32x4 v = (u32x4){0u, 0u, 0u, 0u};
        if (pos >= 0 && pos < L) v = *(const u32x4*)(Z + (size_t)(row0 + pos) * 256 + c4);
        *(LAS u32x4*)(zs + rr * 256 + c4) = v; }
    const int cp = tid & 255, th = tid >> 8;
    float w0[31], w1[31];
    const float* wd = p.w_dw + (size_t)l * 31 * 512 + 2 * cp;
#pragma unroll
    for (int j = 0; j < 31; ++j) { w0[j] = wd[j * 512]; w1[j] = wd[j * 512 + 1]; }
    const float b0 = p.b_dw[l * 512 + 2 * cp], b1 = p.b_dw[l * 512 + 2 * cp + 1];
    __syncthreads();
    for (int i = 0; i < 16; ++i) { const int tt = th * 16 + i; float a0 = b0, a1 = b1;
#pragma unroll
        for (int j = 0; j < 31; ++j) { const unsigned v = zs[(tt + j) * 256 + cp]; a0 += w0[j] * bf_lo(v); a1 += w1[j] * bf_hi(v); }
        co[tt * 512 + 2 * cp] = a0; co[tt * 512 + 2 * cp + 1] = a1; }
    __syncthreads();
    const float* gl = p.g_conv_ln + l * 512 + lane * 8; const float* bl = p.b_conv_ln + l * 512 + lane * 8;
    for (int q = 0; q < 4; ++q) { const int tt = wid * 4 + q;
        float v[8]; float s = 0.f;
#pragma unroll
        for (int j = 0; j < 8; ++j) { v[j] = co[tt * 512 + lane * 8 + j]; s += v[j]; }
        const float mean = wave_sum(s) * (1.0f / 512.0f); float s2 = 0.f;
#pragma unroll
        for (int j = 0; j < 8; ++j) { v[j] -= mean; s2 += v[j] * v[j]; }
        const float rstd = rsqrtf(wave_sum(s2) * (1.0f / 512.0f) + EPS);
#pragma unroll
        for (int j = 0; j < 8; ++j) { const float y = v[j] * rstd * gl[j] + bl[j]; v[j] = y * fsigmoid(y); }
        u32x4 o; o.x = pk2(v[0], v[1]); o.y = pk2(v[2], v[3]); o.z = pk2(v[4], v[5]); o.w = pk2(v[6], v[7]);
        *(u32x4*)((bf16_t*)(ws + O_CAT) + (size_t)(row0 + pos0 + tt) * D + 512 + lane * 8) = o; }
    __syncthreads();
}


typedef float f32x2 __attribute__((ext_vector_type(2)));
__device__ __forceinline__ f32x2 cmul(f32x2 a, f32x2 w) { return (f32x2){a.x * w.x - a.y * w.y, a.x * w.y + a.y * w.x}; }
__device__ __forceinline__ f32x2 tw_rev(float f) { return (f32x2){cos_rev(f), -sin_rev(f)}; }
__device__ __forceinline__ void fft4(f32x2& a0, f32x2& a1, f32x2& a2, f32x2& a3) {
    const f32x2 t0 = a0 + a2, t1 = a0 - a2, t2 = a1 + a3, d = a1 - a3; const f32x2 t3 = (f32x2){d.y, -d.x};
    a0 = t0 + t2; a1 = t1 + t3; a2 = t0 - t2; a3 = t1 - t3;
}
__device__ __forceinline__ void fft16(f32x2 (&v)[16], f32x2 (&o)[16]) {
    constexpr float C1 = 0.9238795325112867f, S1 = 0.3826834323650898f, C2 = 0.7071067811865476f;
#pragma unroll
    for (int n1 = 0; n1 < 4; ++n1) fft4(v[n1], v[n1 + 4], v[n1 + 8], v[n1 + 12]);
    v[5] = cmul(v[5], (f32x2){C1, -S1}); v[9] = cmul(v[9], (f32x2){C2, -C2}); v[13] = cmul(v[13], (f32x2){S1, -C1});
    v[6] = cmul(v[6], (f32x2){C2, -C2}); v[10] = (f32x2){v[10].y, -v[10].x}; v[14] = cmul(v[14], (f32x2){-C2, -C2});
    v[7] = cmul(v[7], (f32x2){S1, -C1}); v[11] = cmul(v[11], (f32x2){-C2, -C2}); v[15] = cmul(v[15], (f32x2){-C1, S1});
#pragma unroll
    for (int p = 0; p < 4; ++p) { fft4(v[4 * p], v[4 * p + 1], v[4 * p + 2], v[4 * p + 3]);
        o[p] = v[4 * p]; o[4 + p] = v[4 * p + 1]; o[8 + p] = v[4 * p + 2]; o[12 + p] = v[4 * p + 3]; }
}
__device__ __forceinline__ void fft8(f32x2 (&v)[8], f32x2 (&o)[8]) {
    constexpr float C2 = 0.7071067811865476f;
    f32x2 s0 = v[0] + v[4], s1 = v[1] + v[5], s2 = v[2] + v[6], s3 = v[3] + v[7];
    f32x2 d0 = v[0] - v[4], d1 = cmul(v[1] - v[5], (f32x2){C2, -C2}), d2 = v[2] - v[6], d3 = cmul(v[3] - v[7], (f32x2){-C2, -C2});
    d2 = (f32x2){d2.y, -d2.x};
    fft4(s0, s1, s2, s3); fft4(d0, d1, d2, d3);
    o[0] = s0; o[2] = s1; o[4] = s2; o[6] = s3; o[1] = d0; o[3] = d1; o[5] = d2; o[7] = d3;
}
__device__ __forceinline__ void fft_item(const Params& p, LAS unsigned char* lds, int b, int n0) {
    unsigned char* ws = p.ws;
    const int tid = opaque_tid();
    constexpr int CS = 2176;
    LAS f32x2* Z = (LAS f32x2*)lds;
    const bf16_t* AB = (const bf16_t*)(ws + O_ABT);
#pragma unroll
    for (int i = 0; i < 2; ++i) { const int ch = tid + 512 * i, col = ch >> 8, pc = ch & 255;
        const bf16_t* src = AB + (size_t)(n0 + col) * 16384 + b * 4096 + pc * 8;
        const u32x4 a = *(const u32x4*)src, bb = *(const u32x4*)(src + 2048);
        LAS f32x2* d = Z + col * CS + pc * 8 + (pc >> 1);
#pragma unroll
        for (int q = 0; q < 4; ++q) { d[2 * q] = (f32x2){bf_lo(a[q]), -bf_lo(bb[q])}; d[2 * q + 1] = (f32x2){bf_hi(a[q]), -bf_hi(bb[q])}; } }
    __syncthreads();
    const int col = tid >> 7, j = tid & 127;
    LAS f32x2* Zc = Z + col * CS;
    f32x2 v[16], o[16];
#pragma unroll
    for (int r = 0; r < 16; ++r) { const int i = j + 128 * r; v[r] = Zc[i + (i >> 4)]; }
    fft16(v, o);
    __syncthreads();
#pragma unroll
    for (int q = 0; q < 16; ++q) Zc[17 * j + q] = o[q];
    __syncthreads();
    { const int k = j & 15;
#pragma unroll
        for (int r = 0; r < 16; ++r) { const int i = j + 128 * r; v[r] = Zc[i + (i >> 4)]; if (r) v[r] = cmul(v[r], tw_rev((float)(r * k) * (1.0f / 256.0f))); }
        fft16(v, o);
        __syncthreads();
        const int base = (j >> 4) * 256 + k;
#pragma unroll
        for (int q = 0; q < 16; ++q) { const int i = base + 16 * q; Zc[i + (i >> 4)] = o[q]; }
    }
    __syncthreads();
#pragma unroll
    for (int it = 0; it < 2; ++it) { const int jj = tid + 512 * it, c3 = jj >> 8, j3 = jj & 255;
        LAS f32x2* Z3 = Z + c3 * CS; f32x2 a[8], c[8];
#pragma unroll
        for (int r = 0; r < 8; ++r) { const int i = j3 + 256 * r; a[r] = Z3[i + (i >> 4)]; if (r) a[r] = cmul(a[r], tw_rev((float)(r * j3) * (1.0f / 2048.0f))); }
        fft8(a, c);
#pragma unroll
        for (int r = 0; r < 8; ++r) { const int i = j3 + 256 * r; Z3[i + (i >> 4)] = c[r]; } }
    __syncthreads();
    bf16_t* dst = (bf16_t*)(ws + O_CAT) + (size_t)b * SEQ * D + n0;
#pragma unroll
    for (int i = 0; i < 4; ++i) { const int pos = tid + 512 * i, sl = pos + (pos >> 4);
        constexpr float NRM = 0.02209708691207961f;
        u32x2 w; w.x = pk2(Z[sl].x * NRM, Z[CS + sl].x * NRM); w.y = pk2(Z[2 * CS + sl].x * NRM, Z[3 * CS + sl].x * NRM);
        *(u32x2*)(dst + (size_t)pos * D) = w; }
    __syncthreads();
}

__device__ __forceinline__ void phase_mix(const Params& p, LAS unsigned char* lds, LAS int* s_item, int l, int rep) {
    unsigned char* ws = p.ws;
    const bool cx = (l == 0);
    const int nA = 64, nFF = 64, nFC = cx ? 1 : 0, nAC = cx ? 8 : 0, nCV = cx ? 36 : 32;
    const int total = nA + nFF + nFC + nAC + nCV;
    const int xcc = (int)(xb_xcc_id() & 7u);
    unsigned live = 0xffu;
    for (int k = 0; k < 8; ++k) {
        const int x = (xcc + k) & 7;
        unsigned* ctr = (unsigned*)(ws + O_MISC) + 16 + (l * 8 + x) * 8;
        if (k == 1) {
            __syncthreads();
            if (threadIdx.x == 0) {
                const unsigned* cb = (const unsigned*)(ws + O_MISC) + 16 + (l * 8) * 8; unsigned c0, c1, c2, c3, c4, c5, c6, c7;
                asm volatile("global_load_dword %0, %8, off sc1\n\t" "global_load_dword %1, %8, off offset:32 sc1\n\t" "global_load_dword %2, %8, off offset:64 sc1\n\t"
                             "global_load_dword %3, %8, off offset:96 sc1\n\t" "global_load_dword %4, %8, off offset:128 sc1\n\t" "global_load_dword %5, %8, off offset:160 sc1\n\t"
                             "global_load_dword %6, %8, off offset:192 sc1\n\t" "global_load_dword %7, %8, off offset:224 sc1\n\t" "s_waitcnt vmcnt(0)"
                             : "=&v"(c0), "=&v"(c1), "=&v"(c2), "=&v"(c3), "=&v"(c4), "=&v"(c5), "=&v"(c6), "=&v"(c7) : "v"(cb) : "memory");
                const unsigned t = (unsigned)total;
                *s_item = (int)((c0 < t ? 1u : 0u) | (c1 < t ? 2u : 0u) | (c2 < t ? 4u : 0u) | (c3 < t ? 8u : 0u) | (c4 < t ? 16u : 0u) | (c5 < t ? 32u : 0u) | (c6 < t ? 64u : 0u) | (c7 < t ? 128u : 0u));
            }
            __syncthreads();
            live = (unsigned)*s_item;
        }
        if (!((live >> x) & 1u)) continue;
        for (;;) {
            __syncthreads();
            if (threadIdx.x == 0) *s_item = (int)atomicAdd(ctr, 1u);
            __syncthreads();
            int it = *s_item;
            if (it >= total) break;
            if (it < nA) { const int qb = it & 15, bh = (it >> 4) * 8 + x; attn_item(p, lds, l, bh >> 3, bh & 7, qb, false); continue; }
            it -= nA;
            if (it < nFF) { const int id = x * 64 + it; fft_item(p, lds, id >> 7, (id & 127) * 4); continue; }
            it -= nFF;
            if (it < nFC) { const int b = x >> 1, pn = x & 1;
                SchedOne S; S.u.a = (const char*)(ws + O_DFTC); S.u.b = (const char*)(ws + O_ABTC) + ((size_t)pn * 256 * 2048 + b * 512) * 2;
                S.u.nt = 8; S.u.kind = 0; S.u.pm = 0; S.u.pn = pn;
                EpiBf16<0> E; E.O = (bf16_t*)(ws + O_CAT) + (size_t)(NLAT + b * CTXL) * D; E.ldc = D;
                pg8::gemm_phase(lds, 512, 2048, S, E);
                continue; }
            it -= nFC;
            if (it < nAC) { const int qb = it & 1, bh = (it >> 1) * 8 + x; attn_item(p, lds, l, bh >> 3, bh & 7, qb, true); continue; }
            it -= nAC;
            { const int id = x * nCV + it; if (id < 256) conv_item(p, lds, l, id >> 6, id & 63); else { const int j = id - 256; conv_item(p, lds, l, 4 + (j >> 3), j & 7); } }
        }
    }
}

constexpr int NPH = 16;
__global__ void __launch_bounds__(512, 2) mega(Params p) {
    extern __shared__ __attribute__((aligned(16))) unsigned char shm[];
    LAS unsigned char* lds = (LAS unsigned char*)shm;
    unsigned char* ws = p.ws;
    const int G = gridDim.x, c = blockIdx.x;
    const float* MOD = (const float*)(ws + O_MOD);
    volatile LAS unsigned* xst = (volatile LAS unsigned*)(lds + LDS_BYTES + 16);
    if (threadIdx.x == 0) { xst[0] = 0u; xst[1] = 0u; }
    __syncthreads();
    const XcdBarrier xb = xcd_barrier_post((unsigned*)(ws + O_BAR), xst);
    if (p.ph_lo < 0) cg::this_grid().sync();
    for (int ph = p.ph_lo; ph < p.ph_hi; ++ph) {
        if (ph > p.ph_lo) xcd_barrier(xb);
        if (ph == 0) { phase_prep(p, lds); if (PROBE_DUP & 1) { __syncthreads(); phase_prep(p, lds); } continue; }
        if (ph == 1) {
            {
                for (int it = c; it < 64; it += G) { const int l = it >> 5, g = (it >> 3) & 3, pn = it & 7;
                    SchedOne S; S.u.a = (const char*)(ws + O_MTP + l * SZ_MTP) + (size_t)g * 256 * 256 * 2; S.u.b = (const char*)(ws + O_WINF + l * SZ_WINF) + ((size_t)pn * 256 * 640 + g * 128) * 2;
                    S.u.nt = 4; S.u.kind = 0; S.u.pm = g; S.u.pn = pn;
                    EpiBf16<0> E; E.O = (bf16_t*)(ws + O_WINT + l * SZ_WINT); E.ldc = 2048;
                    pg8::gemm_phase(lds, 256, 640, S, E); }
                for (int it = (G >= 96 ? (c >= 64 ? c - 64 : c + G - 64) : c); it < 32; it += G) { const int l = it >> 4, pm = (it >> 1) & 7, pn = it & 1;
                    SchedOne S; S.u.a = (const char*)(ws + O_WTMP + l * SZ_WTMP) + (size_t)pm * 256 * 512 * 2; S.u.b = (const char*)(ws + O_WPW + l * SZ_WPW) + (size_t)pn * 256 * 512 * 2;
                    S.u.nt = 8; S.u.kind = 0; S.u.pm = pm; S.u.pn = pn;
                    EpiBf16<0> E; E.O = (bf16_t*)(ws + O_WOUTF + l * SZ_WOUTF) + 512; E.ldc = 2048;
                    pg8::gemm_phase(lds, 512, 512, S, E); }
            }
            RowArgs a{}; a.mode = 0; a.hasH = true; a.nrows = NROW; a.xlat = p.x; a.xctx = p.ctx; a.gn = p.g_pre_mix; a.modn = MOD; a.sh_off = 0; a.sc_off = 2048; a.H = (bf16_t*)(ws + O_H);
            phase_rows(a); if (PROBE_DUP & 8) { phase_rows(a); phase_rows(a); for (int q = 0; q < 8; ++q) xcd_barrier(xb); } continue;
        }
        const int l = (ph - 2) / 7, sp = (ph - 2) % 7;
        for (int rep = 0; rep < (((PROBE_DUP & 2) && (sp == 0 || sp == 2 || sp == 4 || sp == 5)) ? 2 : 1); ++rep) {
        const bool cx = (l == 0);
        const float* xl = cx ? p.x : p.out; const float* xc = cx ? p.ctx : (const float*)(ws + O_CX);
        if (sp == 0) { SchedP2 S; S.H = (const char*)(ws + O_H); S.W = (const char*)(ws + O_WINT + l * SZ_WINT); S.G = G; S.c = c; EpiP2 E; E.ws = ws; E.layer = l; pg8::gemm_phase(lds, 2048, 2048, S, E);
            if (cx) {
                LAS float* scr = (LAS float*)lds; const bool std = (G == 256);
                if (!std || c >= 208)
                    for (int j = std ? c - 208 : c; j < 512; j += std ? 48 : G) { const int kt = j >> 6, ntile = j & 63;
                        tr_tile(p.w_in + (size_t)2048 * INC, INC, kt * 256, 512 + ntile * 64, (bf16_t*)(ws + O_WINT + SZ_WINT), 2048, kt * 256, RmWin(), scr); }
            } }
        else if (sp == 1) { phase_mix(p, lds, (LAS int*)(lds + LDS_BYTES), l, 0); }
        else if (sp == 2) { SchedGrid S; S.A = (const char*)(ws + O_CAT); S.B = (const char*)(ws + O_WOUTF + l * SZ_WOUTF); S.lda = 2048; S.ldb = 2048; S.nM = 32; S.nN = 8; S.nt = 32; S.nsplit = cx ? 8 : 0; S.G = G; S.c = c;
            EpiY E; E.Y = (bf16_t*)(ws + O_Y); E.YP = (bf16_t*)(ws + O_YP); E.split_stride = (size_t)NCTX * D; pg8::gemm_phase(lds, 2048, 2048, S, E); }
        else if (sp == 3) { RowArgs a{}; a.mode = 1; a.hasH = true; a.nrows = cx ? NROW : NLAT; a.xlat = xl; a.xctx = xc; a.olat = p.out; a.octx = (float*)(ws + O_CX);
            a.Y = (const bf16_t*)(ws + O_Y); a.YP = (const bf16_t*)(ws + O_YP); a.bias = (const float*)(ws + O_BO) + l * 2048; a.gpost = p.g_post_mix + l * D; a.gn = p.g_pre_mlp + l * D;
            a.mod = MOD + (size_t)l * 5 * 12288; a.modn = a.mod; a.gate_off = 4096; a.sh_off = 6144; a.sc_off = 8192; a.H = (bf16_t*)(ws + O_H); a.x16 = (const bf16_t*)(ws + O_X16); a.o16 = (bf16_t*)(ws + O_X16); a.in16 = !cx; a.out16 = true; phase_rows(a); }
        else if (sp == 4) { SchedGrid S; S.A = (const char*)(ws + O_H); S.B = (const char*)(ws + O_WMI + l * SZ_WMI); S.lda = 2048; S.ldb = 2048; S.nM = cx ? 36 : 32; S.nN = 32; S.nt = 32; S.nsplit = 0; S.G = G; S.c = c;
            EpiBf16<1> E; E.O = (bf16_t*)(ws + O_T); E.ldc = DFF; pg8::gemm_phase(lds, 2048, 2048, S, E);
            if (cx && G == 256 ? c >= 128 : false) {
                LAS float* scr = (LAS float*)lds;
                for (int j = c - 128; j < 2048; j += 128) {
                    if (j < 1024) { const int kt = j >> 7, ntile = j & 127; tr_tile(p.w_mlp_in + (size_t)2048 * 8192, 8192, kt * 256, ntile * 64, (bf16_t*)(ws + O_WMI + SZ_WMI), 2048, kt * 256, RmId(), scr); }
                    else { const int q = j - 1024, kt = q >> 5, ntile = q & 31; tr_tile(p.w_mlp_out + (size_t)8192 * 2048, 2048, kt * 256, ntile * 64, (bf16_t*)(ws + O_WMO + SZ_WMO), 8192, kt * 256, RmId(), scr); }
                }
            } else if (cx && G != 256) {
                LAS float* scr = (LAS float*)lds;
                for (int j = c; j < 2048; j += G) {
                    if (j < 1024) { const int kt = j >> 7, ntile = j & 127; tr_tile(p.w_mlp_in + (size_t)2048 * 8192, 8192, kt * 256, ntile * 64, (bf16_t*)(ws + O_WMI + SZ_WMI), 2048, kt * 256, RmId(), scr); }
                    else { const int q = j - 1024, kt = q >> 5, ntile = q & 31; tr_tile(p.w_mlp_out + (size_t)8192 * 2048, 2048, kt * 256, ntile * 64, (bf16_t*)(ws + O_WMO + SZ_WMO), 8192, kt * 256, RmId(), scr); }
                }
            } }
        else if (sp == 5) { SchedGrid S; S.A = (const char*)(ws + O_T); S.B = (const char*)(ws + O_WMO + l * SZ_WMO); S.lda = 8192; S.ldb = 8192; S.nM = 32; S.nN = 8; S.nt = 128; S.nsplit = cx ? 8 : 0; S.G = G; S.c = c;
            EpiY E; E.Y = (bf16_t*)(ws + O_Y); E.YP = (bf16_t*)(ws + O_YP); E.split_stride = (size_t)NCTX * D; pg8::gemm_phase(lds, 8192, 8192, S, E); }
        else { RowArgs a{}; a.mode = 1; a.hasH = cx; a.nrows = cx ? NROW : NLAT; a.xlat = p.out; a.xctx = (const float*)(ws + O_CX); a.olat = p.out; a.octx = (float*)(ws + O_CX);
            a.Y = (const bf16_t*)(ws + O_Y); a.YP = (const bf16_t*)(ws + O_YP); a.bias = nullptr; a.gpost = p.g_post_mlp + l * D; a.gn = p.g_pre_mix + (l + 1 < 2 ? l + 1 : l) * D;
            a.mod = MOD + (size_t)l * 5 * 12288; a.modn = MOD + (size_t)(l + 1 < 2 ? l + 1 : l) * 5 * 12288; a.gate_off = 10240; a.sh_off = 0; a.sc_off = 2048; a.H = (bf16_t*)(ws + O_H); a.x16 = (const bf16_t*)(ws + O_X16); a.o16 = (bf16_t*)(ws + O_X16); a.in16 = true; a.out16 = cx; phase_rows(a); }
        }
    }
}

extern "C" void kernel_launch(void* const* d_in, const int* in_sizes, int n_in, void* d_out, int out_size, void* d_ws, size_t ws_size, hipStream_t stream) {
    static int grid = 0;
    if (grid == 0) {
        if (n_in != 26 || ws_size < WS_END) { fprintf(stderr, "kernel_launch: unexpected n_in %d or workspace %zu < %zu\n", n_in, ws_size, (size_t)WS_END); }
        int dev = 0, cus = 0, per_cu = 0;
        (void)hipGetDevice(&dev); (void)hipDeviceGetAttribute(&cus, hipDeviceAttributeMultiprocessorCount, dev);
        (void)hipFuncSetAttribute((const void*)mega, hipFuncAttributeMaxDynamicSharedMemorySize, LDS_TOTAL);
        (void)hipOccupancyMaxActiveBlocksPerMultiprocessor(&per_cu, (const void*)mega, NTHR, LDS_TOTAL);
        if (per_cu < 1) { fprintf(stderr, "kernel_launch: occupancy query says %d blocks/CU\n", per_cu); per_cu = 1; }
        (void)hipGetLastError();
        grid = cus * 1;
    }
    (void)hipMemsetAsync((unsigned char*)d_ws + O_BAR, 0, 16384, stream);
    Params p{};
    const float** f = (const float**)&p;
    for (int i = 0; i < 26; ++i) f[i] = (const float*)d_in[i];
    p.out = (float*)d_out; p.ws = (unsigned char*)d_ws;
#if MK_MULTI
    for (int ph = 0; ph < NPH; ++ph) { p.ph_lo = ph; p.ph_hi = ph + 1; hipLaunchKernelGGL(mega, dim3(grid), dim3(NTHR), LDS_TOTAL, stream, p); }
#else
    p.ph_lo = 0; p.ph_hi = NPH;
    void* args[] = {&p};
    hipError_t e = hipLaunchCooperativeKernel((const void*)mega, dim3(grid), dim3(NTHR), args, LDS_TOTAL, stream);
    if (e != hipSuccess) fprintf(stderr, "cooperative launch failed: %s (grid %d)\n", hipGetErrorString(e), grid);
#endif
}
```

```cpp
#include <hip/hip_runtime.h>
#include <hip/hip_cooperative_groups.h>
#include <cstdio>
namespace cg = cooperative_groups;

#ifndef MK_MULTI
#define MK_MULTI 0
#endif

#ifndef PROBE_DUP
#define PROBE_DUP 0
#endif
#define LAS __attribute__((address_space(3)))
typedef unsigned short bf16_t;
typedef short bf16x8 __attribute__((ext_vector_type(8)));
typedef float f32x4 __attribute__((ext_vector_type(4)));
typedef float f32x16 __attribute__((ext_vector_type(16)));
typedef unsigned u32x4 __attribute__((ext_vector_type(4)));
typedef unsigned u32x2 __attribute__((ext_vector_type(2)));

constexpr int D = 2048, NB = 4, SEQ = 2048, CTXL = 256, NLAT = NB * SEQ, NCTX = NB * CTXL, NROW = NLAT + NCTX;
constexpr int DFF = 8192, LK = CTXL + SEQ, INC = 4608, NH = 8;
constexpr float EPS = 1e-6f;
constexpr float QSCALE = 0.125f * 1.4426950408889634f;
constexpr int NTHR = 512;
constexpr int LDS_BYTES = 131072;
constexpr int LDS_TOTAL = LDS_BYTES + 64;

constexpr size_t al256(size_t x) { return (x + 255) & ~(size_t)255; }
constexpr size_t SZ_WINT = (size_t)5120 * 2048 * 2, SZ_WINF = (size_t)2048 * 640 * 2, SZ_MTP = (size_t)1024 * 256 * 2, SZ_WOUTF = (size_t)2048 * 2048 * 2,
                 SZ_WTMP = (size_t)2048 * 512 * 2, SZ_WPW = (size_t)512 * 512 * 2, SZ_WMI = (size_t)8192 * 2048 * 2, SZ_WMO = SZ_WMI;
constexpr size_t O_WINT = 0;
constexpr size_t O_WINF = O_WINT + 2 * SZ_WINT;
constexpr size_t O_MTP = O_WINF + 2 * SZ_WINF;
constexpr size_t O_WOUTF = O_MTP + 2 * SZ_MTP;
constexpr size_t O_WTMP = O_WOUTF + 2 * SZ_WOUTF;
constexpr size_t O_WPW = O_WTMP + 2 * SZ_WTMP;
constexpr size_t O_WMI = O_WPW + 2 * SZ_WPW;
constexpr size_t O_WMO = O_WMI + 2 * SZ_WMI;
constexpr size_t O_DFT = O_WMO + 2 * SZ_WMO;
constexpr size_t O_DFTC = O_DFT + (size_t)2048 * 4096 * 2;
constexpr size_t O_MOD = O_DFTC + (size_t)256 * 512 * 2;
constexpr size_t O_BO = O_MOD + al256((size_t)2 * 5 * 12288 * 4);
constexpr size_t O_ROPE = O_BO + (size_t)2 * 2048 * 4;
constexpr size_t O_MISC = O_ROPE + (size_t)2048 * 64 * 4;
constexpr size_t O_KMAX = O_MISC + 1024;
constexpr size_t O_CX = O_MISC + 2048;
constexpr size_t O_H = O_CX + (size_t)NCTX * D * 4;
constexpr size_t O_ABT = O_H + (size_t)NROW * D * 2;
constexpr size_t O_ABTC = O_ABT + (size_t)512 * 16384 * 2;
constexpr size_t O_Z = O_ABTC + (size_t)512 * 2048 * 2;
constexpr size_t O_Q = O_Z + (size_t)NROW * 512 * 2;
constexpr size_t O_KK = O_Q + (size_t)NROW * 1024 * 2;
constexpr size_t O_VT = O_KK + (size_t)NB * NH * 2 * LK * 64 * 2;
constexpr size_t O_CAT = O_VT + (size_t)NB * NH * 128 * LK * 2;
constexpr size_t O_Y = O_CAT + (size_t)NROW * D * 2;
constexpr size_t O_YP = O_Y + (size_t)NROW * D * 4;
constexpr size_t O_T = O_YP + (size_t)8 * NCTX * D * 4;
constexpr size_t O_BAR = O_T + (size_t)NROW * DFF * 2;
constexpr size_t O_X16 = O_BAR + 16384;
constexpr size_t WS_END = O_X16 + (size_t)NROW * D * 2;

struct Params {
    const float *x, *c, *ctx, *c_ctx, *w_ada, *b_ada, *g_pre_mix, *g_post_mix, *g_pre_mlp, *g_post_mlp, *w_in, *w_out, *w_fourier, *w_dw, *b_dw,
        *g_conv_ln, *b_conv_ln, *w_conv_pw, *b_conv_pw, *lq1, *lk1, *lq2, *lk2, *g_subln, *w_mlp_in, *w_mlp_out;
    float* out; unsigned char* ws; int ph_lo, ph_hi;
};

__device__ __forceinline__ unsigned pk2(float lo, float hi) { unsigned r; asm volatile("v_cvt_pk_bf16_f32 %0, %1, %2" : "=v"(r) : "v"(lo), "v"(hi)); return r; }
__device__ __forceinline__ float bf_lo(unsigned v) { return __uint_as_float(v << 16); }
__device__ __forceinline__ float bf_hi(unsigned v) { return __uint_as_float(v & 0xffff0000u); }
__device__ __forceinline__ float wave_sum(float v) {
#pragma unroll
    for (int o = 1; o < 64; o <<= 1) v += __shfl_xor(v, o);
    return v;
}
__device__ __forceinline__ int opaque_tid() { int t = threadIdx.x; asm volatile("" : "+v"(t)); return t; }
__device__ __forceinline__ float fsigmoid(float x) { return __builtin_amdgcn_rcpf(1.0f + __expf(-x)); }
__device__ __forceinline__ float cos_rev(float r) { return __builtin_amdgcn_cosf(r); }
__device__ __forceinline__ float sin_rev(float r) { return __builtin_amdgcn_sinf(r); }


#define XB_TMO      128
#define XB_XCNT(j)  (256  + 64 * (j))
#define XB_XSUB(j)  (1280 + 64 * (j))
#define XB_XGEN(j)  (2304 + 64 * (j))
#define XB_TOP      3328
#define XB_TOPGEN   3392
#define XCD_BAR_WORDS 3456
#define XB_SPIN_CAP (1u << 22)
__device__ __forceinline__ unsigned xb_ld(unsigned* p)              { return __hip_atomic_load(p, __ATOMIC_RELAXED, __HIP_MEMORY_SCOPE_AGENT); }
__device__ __forceinline__ unsigned xb_add(unsigned* p, unsigned v) { return __hip_atomic_fetch_add(p, v, __ATOMIC_RELAXED, __HIP_MEMORY_SCOPE_AGENT); }
__device__ __forceinline__ unsigned xb_xcc_id() { return (unsigned)__builtin_amdgcn_s_getreg((3 << 11) | 20) & 0xFu; }
#define XB_SPIN(cond, bar) do { unsigned _sp = 0; while (cond) { __builtin_amdgcn_s_sleep(1); \
    if ((++_sp & 255u) == 0u) { if (xb_ld(&(bar)[XB_TMO])) break; if (_sp > XB_SPIN_CAP) { atomicAdd(&(bar)[XB_TMO], 1u); break; } } } } while (0)
struct XcdBarrier { unsigned* bar; unsigned x; volatile LAS unsigned* st; };
__device__ __forceinline__ XcdBarrier xcd_barrier_post(unsigned* bar, volatile LAS unsigned* st) {
    XcdBarrier b; b.bar = bar; b.x = xb_xcc_id(); b.st = st;
    if (threadIdx.x == 0) (void)xb_add(&bar[XB_XCNT(b.x)], 1u);
    return b;
}
__device__ __forceinline__ void xcd_barrier_complete(unsigned* bar, unsigned x, unsigned& nloc, unsigned& nx) {
    const unsigned G = gridDim.x * gridDim.y * gridDim.z;
    unsigned sum, cnt, mine, sp = 0u;
    for (;;) {
        sum = 0u; cnt = 0u; mine = 0u;
        unsigned cc[16];
        {
            const unsigned* cb = &bar[XB_XCNT(0)];
            asm volatile(
                "global_load_dword %0, %16, off sc1\n\t"            "global_load_dword %1, %16, off offset:256 sc1\n\t"
                "global_load_dword %2, %16, off offset:512 sc1\n\t" "global_load_dword %3, %16, off offset:768 sc1\n\t"
                "global_load_dword %4, %16, off offset:1024 sc1\n\t" "global_load_dword %5, %16, off offset:1280 sc1\n\t"
                "global_load_dword %6, %16, off offset:1536 sc1\n\t" "global_load_dword %7, %16, off offset:1792 sc1\n\t"
                "global_load_dword %8, %16, off offset:2048 sc1\n\t" "global_load_dword %9, %16, off offset:2304 sc1\n\t"
                "global_load_dword %10, %16, off offset:2560 sc1\n\t" "global_load_dword %11, %16, off offset:2816 sc1\n\t"
                "global_load_dword %12, %16, off offset:3072 sc1\n\t" "global_load_dword %13, %16, off offset:3328 sc1\n\t"
                "global_load_dword %14, %16, off offset:3584 sc1\n\t" "global_load_dword %15, %16, off offset:3840 sc1\n\t"
                "s_waitcnt vmcnt(0)"
                : "=&v"(cc[0]), "=&v"(cc[1]), "=&v"(cc[2]), "=&v"(cc[3]), "=&v"(cc[4]), "=&v"(cc[5]), "=&v"(cc[6]), "=&v"(cc[7]),
                  "=&v"(cc[8]), "=&v"(cc[9]), "=&v"(cc[10]), "=&v"(cc[11]), "=&v"(cc[12]), "=&v"(cc[13]), "=&v"(cc[14]), "=&v"(cc[15])
                : "v"(cb) : "memory");
        }
#pragma unroll
        for (unsigned j = 0; j < 16; ++j) { const unsigned c = cc[j]; sum += c; cnt += (c > 0u) ? 1u : 0u; mine = (j == x) ? c : mine; }
        if (sum == G) break;
        __builtin_amdgcn_s_sleep(1);
        if ((++sp & 255u) == 0u) { if (xb_ld(&bar[XB_TMO])) break; if (sp > XB_SPIN_CAP) { atomicAdd(&bar[XB_TMO], 1u); break; } }
    }
    nloc = mine > 0u ? mine : 1u; nx = cnt > 0u ? cnt : 1u;
}
__device__ __forceinline__ void xcd_barrier(const XcdBarrier& b) {
    asm volatile("s_waitcnt vmcnt(0)" ::: "memory");
    __syncthreads();
    if (threadIdx.x == 0) {
        unsigned* bar = b.bar;
        __builtin_amdgcn_s_waitcnt(0);
        unsigned nloc = b.st[0], nx = b.st[1];
        if (nloc == 0u) { xcd_barrier_complete(bar, b.x, nloc, nx); b.st[0] = nloc; b.st[1] = nx; }
        const unsigned old = xb_add(&bar[XB_XSUB(b.x)], 1u);
        const unsigned gen = old / nloc;
        if (old + 1u == (gen + 1u) * nloc) {
            __builtin_amdgcn_fence(__ATOMIC_RELEASE, "agent");
            asm volatile("s_waitcnt vmcnt(0)" ::: "memory");
            const unsigned og = xb_add(&bar[XB_TOP], 1u);
            const unsigned tg = og / nx;
            if (og + 1u == (tg + 1u) * nx) xb_add(&bar[XB_TOPGEN], 1u);
            else XB_SPIN(xb_ld(&bar[XB_TOPGEN]) == tg, bar);
            __builtin_amdgcn_fence(__ATOMIC_ACQUIRE, "agent");
            xb_add(&bar[XB_XGEN(b.x)], 1u);
            asm volatile("s_waitcnt vmcnt(0)" ::: "memory");
        } else {
            XB_SPIN(xb_ld(&bar[XB_XGEN(b.x)]) == gen, bar);
            __builtin_amdgcn_fence(__ATOMIC_ACQUIRE, "agent");
            asm volatile("s_waitcnt vmcnt(0)" ::: "memory");
        }
    }
    __syncthreads();
}

namespace pg8 {
constexpr int BM = 256, BK = 64, HALF = 128, HTB = HALF * BK * 2;
__device__ __forceinline__ int lds_byte(int r, int c) { const int st = (r >> 4) * 2 + (c >> 5), rr = r & 15, cc = c & 31, ob = rr * 64 + cc * 2; return st * 1024 + (ob ^ (((ob >> 9) & 1) << 5)); }
__device__ __forceinline__ void stage_rc(int b, int& R, int& C) { const int st = b / 1024, sb = b % 1024, swz = sb ^ (((sb >> 9) & 1) << 5); R = (st >> 1) * 16 + swz / 64; C = (st & 1) * 32 + (swz % 64) / 2; }
__device__ __forceinline__ int perm32(int rho) { const int n = rho >> 4, i = rho & 15; return 8 * (i >> 2) + 4 * n + (i & 3); }

struct Unit { const char* a; const char* b; int nt, kind, pm, pn; };

template <class Epi, class Sched>
__device__ __forceinline__ void gemm_phase(LAS unsigned char* lds, const int lda, const int ldb, const Sched& S, const Epi& E) {
    const int tid = opaque_tid(), wid = __builtin_amdgcn_readfirstlane(tid >> 6), lane = tid & 63, wr = wid >> 2, wc = wid & 3, fr = lane & 15, fq = lane >> 4;
    unsigned voffA[2], voffB[2];
#pragma unroll
    for (int i = 0; i < 2; ++i) { int R, C; stage_rc(tid * 16 + i * 8192, R, C); const int Rb = Epi::PERM ? ((R & ~31) + perm32(R & 31)) : R;
        voffA[i] = (unsigned)(R * lda + C) * 2u; voffB[i] = (unsigned)(Rb * ldb + C) * 2u; }
    const size_t kstep = (size_t)(BK * 2);
    const size_t hstepA = (size_t)HALF * lda * 2, hstepB = (size_t)HALF * ldb * 2;
    const unsigned ldsw = (unsigned)wid * 1024u;
    const int aoff = lds_byte(wr * 64 + fr, fq * 8), boff = lds_byte(wc * 32 + fr, fq * 8);
#define PG8_SA(b, h) (((b) * 2 + (h)) * HTB)
#define PG8_SB(b, h) ((4 + (b) * 2 + (h)) * HTB)
#define PG8_STAGE(bufoff, gbase, voff) do { _Pragma("unroll") for (int _i = 0; _i < 2; ++_i) \
        __builtin_amdgcn_global_load_lds((const unsigned*)((const char*)(gbase) + (voff)[_i]), (LAS unsigned*)(lds + (bufoff) + ldsw + _i * 8192), 16, 0, 0); } while (0)
#define PG8_LDA(dst, b, h) do { _Pragma("unroll") for (int m = 0; m < 4; ++m) _Pragma("unroll") for (int k = 0; k < 2; ++k) dst[m][k] = *(const LAS bf16x8*)(lds + PG8_SA(b, h) + aoff + m * 2048 + k * 1024); } while (0)
#define PG8_LDB(dst, b, h) do { _Pragma("unroll") for (int n = 0; n < 2; ++n) _Pragma("unroll") for (int k = 0; k < 2; ++k) dst[n][k] = *(const LAS bf16x8*)(lds + PG8_SB(b, h) + boff + n * 2048 + k * 1024); } while (0)
#define PG8_MMA(ai, bj, At, Bt) do { __builtin_amdgcn_s_setprio(1); _Pragma("unroll") for (int m = 0; m < 4; ++m) _Pragma("unroll") for (int n = 0; n < 2; ++n) _Pragma("unroll") for (int k = 0; k < 2; ++k) \
        acc[ai][bj][m][n] = __builtin_amdgcn_mfma_f32_16x16x32_bf16(Bt[n][k], At[m][k], acc[ai][bj][m][n], 0, 0, 0); __builtin_amdgcn_s_setprio(0); } while (0)
#define PG8_WAIT_V(n) asm volatile("s_waitcnt vmcnt(" #n ")" ::: "memory")
#define PG8_WAIT_L(n) asm volatile("s_waitcnt lgkmcnt(" #n ")" ::: "memory")
#define PG8_BAR __builtin_amdgcn_s_barrier()
#define PG8_SCHED __builtin_amdgcn_sched_barrier(0)
    Unit cur, nxt; int ui = 0;
    if (!S.next(0, cur)) return;
    f32x4 acc[2][2][4][2];
#pragma unroll
    for (int a = 0; a < 2; ++a)
#pragma unroll
        for (int b = 0; b < 2; ++b)
#pragma unroll
            for (int m = 0; m < 4; ++m)
#pragma unroll
                for (int n = 0; n < 2; ++n) acc[a][b][m][n] = (f32x4){0.f, 0.f, 0.f, 0.f};
    bf16x8 At[4][2], B0[2][2], B1[2][2];
    const char* cA = cur.a; const char* cB = cur.b;
    PG8_STAGE(PG8_SB(0, 0), cB, voffB); PG8_STAGE(PG8_SA(0, 0), cA, voffA); PG8_STAGE(PG8_SB(0, 1), cB + hstepB, voffB); PG8_STAGE(PG8_SA(0, 1), cA + hstepA, voffA);
    PG8_STAGE(PG8_SB(1, 0), cB + kstep, voffB); PG8_STAGE(PG8_SA(1, 0), cA + kstep, voffA); PG8_STAGE(PG8_SB(1, 1), cB + hstepB + kstep, voffB);
    if (wr == 1) PG8_BAR;
    PG8_WAIT_V(10); PG8_BAR;
    PG8_WAIT_V(6); PG8_BAR;
    for (;;) {
        const bool has_next = S.next(ui + 1, nxt);
        const char* nA = has_next ? nxt.a : cA; const char* nB = has_next ? nxt.b : cB;
        const int nt = cur.nt;
        for (int t = 0; t < nt; t += 2) {
            const bool last = (t == nt - 2);
            const char* a1 = cA + (size_t)(t + 1) * kstep;
            const char* a2 = last ? nA : cA + (size_t)(t + 2) * kstep; const char* b2 = last ? nB : cB + (size_t)(t + 2) * kstep;
            const char* a3 = a2 + kstep; const char* b3 = b2 + kstep;
            PG8_LDB(B0, 0, 0); PG8_SCHED; PG8_LDA(At, 0, 0); PG8_STAGE(PG8_SA(1, 1), a1 + hstepA, voffA);
            PG8_WAIT_L(8); PG8_BAR; PG8_WAIT_L(0); PG8_MMA(0, 0, At, B0); PG8_BAR; PG8_SCHED;
            PG8_LDB(B1, 0, 1); PG8_STAGE(PG8_SB(0, 0), b2, voffB);
            PG8_BAR; PG8_WAIT_L(0); PG8_MMA(0, 1, At, B1); PG8_BAR;
            PG8_LDA(At, 0, 1); PG8_STAGE(PG8_SA(0, 0), a2, voffA);
            PG8_BAR; PG8_WAIT_L(0); PG8_MMA(1, 0, At, B0); PG8_BAR; PG8_SCHED;
            PG8_STAGE(PG8_SB(0, 1), b2 + hstepB, voffB);
            PG8_WAIT_V(6); PG8_BAR; PG8_MMA(1, 1, At, B1); PG8_BAR;
            PG8_LDB(B0, 1, 0); PG8_SCHED; PG8_LDA(At, 1, 0); PG8_STAGE(PG8_SA(0, 1), a2 + hstepA, voffA);
            PG8_WAIT_L(8); PG8_BAR; PG8_WAIT_L(0); PG8_MMA(0, 0, At, B0); PG8_BAR; PG8_SCHED;
            PG8_LDB(B1, 1, 1); PG8_STAGE(PG8_SB(1, 0), b3, voffB);
            PG8_BAR; PG8_WAIT_L(0); PG8_MMA(0, 1, At, B1); PG8_BAR;
            PG8_LDA(At, 1, 1); PG8_STAGE(PG8_SA(1, 0), a3, voffA);
            PG8_BAR; PG8_WAIT_L(0); PG8_MMA(1, 0, At, B0); PG8_BAR; PG8_SCHED;
            PG8_STAGE(PG8_SB(1, 1), b3 + hstepB, voffB);
            PG8_WAIT_V(6); PG8_BAR; PG8_MMA(1, 1, At, B1); PG8_BAR;
        }
        { int lane2; asm volatile("v_mov_b32 %0, %1" : "=v"(lane2) : "v"(lane));
          E(acc, cur, wr, wc, lane2 & 15, lane2 >> 4); }
        if (!has_next) break;
#pragma unroll
        for (int a = 0; a < 2; ++a)
#pragma unroll
            for (int b = 0; b < 2; ++b)
#pragma unroll
                for (int m = 0; m < 4; ++m)
#pragma unroll
                    for (int n = 0; n < 2; ++n) acc[a][b][m][n] = (f32x4){0.f, 0.f, 0.f, 0.f};
        cur = nxt; cA = nA; cB = nB; ++ui;
    }
    PG8_WAIT_V(0);
    if (wr == 0) PG8_BAR;
    PG8_BAR;
#undef PG8_SA
#undef PG8_SB
#undef PG8_STAGE
#undef PG8_LDA
#undef PG8_LDB
#undef PG8_MMA
#undef PG8_WAIT_V
#undef PG8_WAIT_L
#undef PG8_BAR
#undef PG8_SCHED
}
__device__ __forceinline__ int xcd_remap(int wgid, int nwg) { const int q = nwg / 8, r = nwg % 8, xcd = wgid % 8, off = wgid / 8; return (xcd < r ? xcd * (q + 1) : r * (q + 1) + (xcd - r) * q) + off; }
__device__ __forceinline__ void grid_decode(int w, int nM, int nN, int& pm, int& pn) { const int nig = 8 * nN, gid = w / nig, fm = gid * 8, gsz = (nM - fm) < 8 ? (nM - fm) : 8; pm = fm + ((w % nig) % gsz); pn = (w % nig) / gsz; }
}
using pg8::Unit;

enum { K_TFOLD = 0, K_TV = 1, K_NGLU = 2, K_NQ = 3, K_NK = 4 };
struct SchedP2 {
    const char* H; const char* W; int G, c;
    __device__ __forceinline__ bool next(int i, Unit& u) const {
        const int L = i * G + c; if (L >= 720) return false;
        int w = pg8::xcd_remap(L, 720); int pm, pn;
        { const int x = w / 90, j = w - 90 * x; w = j < 36 ? 36 * x + j : 288 + 54 * x + (j - 36); }
        if (w < 288) { pg8::grid_decode(w, 8, 36, pm, pn); u.kind = pm < 4 ? K_TFOLD : K_TV; u.a = W + (size_t)pm * 256 * 4096; u.b = H + (size_t)pn * 256 * 4096; }
        else { w -= 288; pg8::grid_decode(w, 36, 12, pm, pn); u.kind = K_NGLU + (pn >> 2); u.a = H + (size_t)pm * 256 * 4096; u.b = W + (size_t)(2048 + pn * 256) * 4096; }
        u.pm = pm; u.pn = pn; u.nt = 32; return true;
    }
};
struct SchedGrid {
    const char* A; const char* B; int lda, ldb, nM, nN, nt, nsplit  , G, c;
    __device__ __forceinline__ bool next(int i, Unit& u) const {
        const int nmain = nM * nN, ntot = nmain + 4 * nN * nsplit;
        const int L = i * G + c; if (L >= ntot) return false;
        if (L < nmain) { const int w = pg8::xcd_remap(L, nmain); int pm, pn; pg8::grid_decode(w, nM, nN, pm, pn);
            u.kind = 0; u.pm = pm; u.pn = pn; u.nt = nt; u.a = A + (size_t)pm * 256 * lda * 2; u.b = B + (size_t)pn * 256 * ldb * 2; }
        else { const int idx = L - nmain, s = idx & 7, rest = idx >> 3, pn = rest % nN, pm = 32 + rest / nN; const int snt = nt >> 3;
            u.kind = 1 + s; u.pm = pm; u.pn = pn; u.nt = snt; u.a = A + (size_t)pm * 256 * lda * 2 + (size_t)s * snt * 128; u.b = B + (size_t)pn * 256 * ldb * 2 + (size_t)s * snt * 128; }
        return true;
    }
};
struct SchedOne { Unit u; __device__ __forceinline__ bool next(int i, Unit& o) const { if (i) return false; o = u; return true; } };

struct EpiP2 {
    static constexpr bool PERM = true;
    unsigned char* ws; int layer;
    __device__ __forceinline__ void operator()(const f32x4 (&acc)[2][2][4][2], const Unit& u, int wr, int wc, int fr, int fq) const {
        if (u.kind == K_TFOLD || u.kind == K_TV) {
#pragma unroll
            for (int ai = 0; ai < 2; ++ai)
#pragma unroll
                for (int m = 0; m < 4; ++m) {
                    const int rr = 128 * ai + 64 * wr + 16 * m + fr;
#pragma unroll
                    for (int bj = 0; bj < 2; ++bj) {
                        const int tok = 256 * u.pn + 128 * bj + 32 * wc + 8 * fq;
                        const f32x4 v0 = acc[ai][bj][m][0], v1 = acc[ai][bj][m][1];
                        u32x4 w; w.x = pk2(v0[0], v0[1]); w.y = pk2(v0[2], v0[3]); w.z = pk2(v1[0], v1[1]); w.w = pk2(v1[2], v1[3]);
                        const bool lat = tok < NLAT; const int t2 = tok - NLAT;
                        const int b = lat ? (tok >> 11) : (t2 >> 8), pos = lat ? (tok & 2047) : (t2 & 255);
                        bf16_t* dst;
                        if (u.kind == K_TFOLD) { const int g = u.pm, cs = rr >> 7, e = rr & 127;
                            dst = lat ? (bf16_t*)(ws + O_ABT) + (size_t)(g * 128 + e) * 16384 + b * 4096 + cs * 2048 + pos
                                      : (bf16_t*)(ws + O_ABTC) + (size_t)(g * 128 + e) * 2048 + b * 512 + cs * 256 + pos; }
                        else { const int n2 = 256 * (u.pm - 4) + rr, h = n2 >> 7, e = n2 & 127;
                            dst = (bf16_t*)(ws + O_VT) + ((size_t)(b * NH + h) * 128 + e) * LK + (lat ? 256 + pos : pos); }
                        *(u32x4*)dst = w;
                    }
                }
        } else {
            const float* rope = (const float*)(ws + O_ROPE);
            float kmx0 = 0.f, kmx1 = 0.f;
            const int pnl = u.pn & 3;
            if (u.kind == K_NGLU) {
#pragma unroll
                for (int ai = 0; ai < 2; ++ai)
#pragma unroll
                    for (int m = 0; m < 4; ++m) {
                        const int tok = 256 * u.pm + 128 * ai + 64 * wr + 16 * m + fr;
#pragma unroll
                        for (int bj = 0; bj < 2; ++bj) {
                            const f32x4 v0 = acc[ai][bj][m][0], v1 = acc[ai][bj][m][1];
                            const int cl = 256 * pnl + 128 * bj + 32 * wc + 8 * fq;
                            u32x2 w; w.x = pk2(v0[0] * fsigmoid(v1[0]), v0[1] * fsigmoid(v1[1])); w.y = pk2(v0[2] * fsigmoid(v1[2]), v0[3] * fsigmoid(v1[3]));
                            *(u32x2*)((bf16_t*)(ws + O_Z) + (size_t)tok * 512 + (cl >> 1)) = w;
                        }
                    }
            } else {
                const int d1 = ((wc & 1) * 4 + fq) * 4;
                f32x4 rc[2][4], rs[2][4];
#pragma unroll
                for (int ai = 0; ai < 2; ++ai)
#pragma unroll
                    for (int m = 0; m < 4; ++m) { const int tok = 256 * u.pm + 128 * ai + 64 * wr + 16 * m + fr;
                        const float* rp = rope + (size_t)(tok < NLAT ? (tok & 2047) : 0) * 64 + d1;
                        rc[ai][m] = *(const f32x4*)rp; rs[ai][m] = *(const f32x4*)(rp + 32); }
#pragma unroll
                for (int ai = 0; ai < 2; ++ai)
#pragma unroll
                    for (int m = 0; m < 4; ++m) {
                        const int tok = 256 * u.pm + 128 * ai + 64 * wr + 16 * m + fr;
                        const bool lat = tok < NLAT; const int t2 = tok - NLAT;
                        const int b = lat ? (tok >> 11) : (t2 >> 8), pos = lat ? (tok & 2047) : (t2 & 255);
                        const f32x4 cs = lat ? rc[ai][m] : (f32x4){1.f, 1.f, 1.f, 1.f}, sn = lat ? rs[ai][m] : (f32x4){0.f, 0.f, 0.f, 0.f};
#pragma unroll
                        for (int bj = 0; bj < 2; ++bj) {
                            const f32x4 v0 = acc[ai][bj][m][0], v1 = acc[ai][bj][m][1];
                            const int blk = 4 * pnl + 2 * bj + (wc >> 1);
                            f32x4 o1 = v0 * cs - v1 * sn, o2 = v1 * cs + v0 * sn;
                            if (u.kind == K_NQ) { o1 = o1 * QSCALE; o2 = o2 * QSCALE;
                                bf16_t* dst = (bf16_t*)(ws + O_Q) + (size_t)tok * 1024 + blk * 64 + d1;
                                u32x2 w1, w2; w1.x = pk2(o1[0], o1[1]); w1.y = pk2(o1[2], o1[3]); w2.x = pk2(o2[0], o2[1]); w2.y = pk2(o2[2], o2[3]);
                                *(u32x2*)dst = w1; *(u32x2*)(dst + 32) = w2;
                            } else {
                                const int key = lat ? 256 + pos : pos;
                                { float ps = (o1[0] * o1[0] + o1[1] * o1[1]) + (o1[2] * o1[2] + o1[3] * o1[3]) + (o2[0] * o2[0] + o2[1] * o2[1]) + (o2[2] * o2[2] + o2[3] * o2[3]);
                                  ps += __shfl_xor(ps, 16); ps += __shfl_xor(ps, 32);
                                  if (bj == 0) kmx0 = fmaxf(kmx0, ps); else kmx1 = fmaxf(kmx1, ps); }
                                bf16_t* dst = (bf16_t*)(ws + O_KK) + ((size_t)(b * 16 + blk) * LK + key) * 64 + d1;
                                u32x2 w1, w2; w1.x = pk2(o1[0], o1[1]); w1.y = pk2(o1[2], o1[3]); w2.x = pk2(o2[0], o2[1]); w2.y = pk2(o2[2], o2[3]);
                                *(u32x2*)dst = w1; *(u32x2*)(dst + 32) = w2;
                            }
                        }
                    }
            }
            if (u.kind == K_NK) {
#pragma unroll
                for (int o = 1; o < 16; o <<= 1) { kmx0 = fmaxf(kmx0, __shfl_xor(kmx0, o)); kmx1 = fmaxf(kmx1, __shfl_xor(kmx1, o)); }
                const int tok0 = 256 * u.pm; const int b = tok0 < NLAT ? (tok0 >> 11) : ((tok0 - NLAT) >> 8);
                const int blk0 = 4 * (u.pn & 3) + (wc >> 1);
                if (fr == 0 && fq == 0) { unsigned* km = (unsigned*)(ws + O_KMAX) + layer * 64 + b * 16 + blk0;
                    atomicMax(km, __float_as_uint(2.0f * kmx0)); atomicMax(km + 2, __float_as_uint(2.0f * kmx1)); }
            }
        }
    }
};
struct EpiY {
    static constexpr bool PERM = true;
    bf16_t* Y; bf16_t* YP; size_t split_stride;
    __device__ __forceinline__ void operator()(const f32x4 (&acc)[2][2][4][2], const Unit& u, int wr, int wc, int fr, int fq) const {
        const int row0 = wr * 64 + fr, col0 = u.pn * 256 + wc * 32 + 8 * fq;
        bf16_t* base = u.kind == 0 ? Y + (size_t)u.pm * 256 * D : YP + (size_t)(u.kind - 1) * split_stride + (size_t)(u.pm - 32) * 256 * D;
#pragma unroll
        for (int ai = 0; ai < 2; ++ai)
#pragma unroll
            for (int m = 0; m < 4; ++m) { bf16_t* rowp = base + (size_t)(row0 + ai * 128 + m * 16) * D + col0;
#pragma unroll
                for (int bj = 0; bj < 2; ++bj) { const f32x4 v0 = acc[ai][bj][m][0], v1 = acc[ai][bj][m][1];
                    u32x4 w; w.x = pk2(v0[0], v0[1]); w.y = pk2(v0[2], v0[3]); w.z = pk2(v1[0], v1[1]); w.w = pk2(v1[2], v1[3]);
                    *(u32x4*)(rowp + bj * 128) = w; } }
    }
};

template <int ACT  > struct EpiBf16 {
    static constexpr bool PERM = true;
    bf16_t* O; int ldc;
    __device__ __forceinline__ void operator()(const f32x4 (&acc)[2][2][4][2], const Unit& u, int wr, int wc, int fr, int fq) const {
        const int row0 = u.pm * 256 + wr * 64 + fr, col0 = u.pn * 256 + wc * 32 + 8 * fq;
#pragma unroll
        for (int ai = 0; ai < 2; ++ai)
#pragma unroll
            for (int m = 0; m < 4; ++m) { bf16_t* rowp = O + (size_t)(row0 + ai * 128 + m * 16) * ldc + col0;
#pragma unroll
                for (int bj = 0; bj < 2; ++bj) { f32x4 v0 = acc[ai][bj][m][0], v1 = acc[ai][bj][m][1];
                    if (ACT == 1) {
#pragma unroll
                        for (int j = 0; j < 4; ++j) { const float a = fmaxf(v0[j], 0.f), b = fmaxf(v1[j], 0.f); v0[j] = a * a; v1[j] = b * b; } }
                    u32x4 w; w.x = pk2(v0[0], v0[1]); w.y = pk2(v0[2], v0[3]); w.z = pk2(v1[0], v1[1]); w.w = pk2(v1[2], v1[3]);
                    *(u32x4*)(rowp + bj * 128) = w; } }
    }
};

template <class RowMap>
__device__ __forceinline__ void tr_tile(const float* src, int ldn, int k0, int n0, bf16_t* dst, int ldk, int kdst0, const RowMap& rm, LAS float* scr) {
    const int tid = opaque_tid();
    f32x4 v[8];
#pragma unroll
    for (int i = 0; i < 8; ++i) { const int idx = tid + 512 * i, kk = idx >> 4, c = (idx & 15) * 4; v[i] = *(const f32x4*)(src + (size_t)(k0 + kk) * ldn + n0 + c); }
#pragma unroll
    for (int i = 0; i < 8; ++i) { const int idx = tid + 512 * i, kk = idx >> 4, c = (idx & 15) * 4;
        scr[kk * 65 + c] = v[i][0]; scr[kk * 65 + c + 1] = v[i][1]; scr[kk * 65 + c + 2] = v[i][2]; scr[kk * 65 + c + 3] = v[i][3]; }
    __syncthreads();
    { const int n = tid >> 3, kc = tid & 7; bf16_t* drow = dst + (size_t)rm(n0 + n) * ldk + kdst0 + kc * 8;
        float tv[4][8];
#pragma unroll
        for (int hf = 0; hf < 4; ++hf) { const LAS float* s = scr + (hf * 64 + kc * 8) * 65 + n;
#pragma unroll
            for (int j = 0; j < 8; ++j) tv[hf][j] = s[j * 65]; }
#pragma unroll
        for (int hf = 0; hf < 4; ++hf) {
            u32x4 o; o.x = pk2(tv[hf][0], tv[hf][1]); o.y = pk2(tv[hf][2], tv[hf][3]); o.z = pk2(tv[hf][4], tv[hf][5]); o.w = pk2(tv[hf][6], tv[hf][7]);
            *(u32x4*)(drow + hf * 64) = o; } }
    __syncthreads();
}
struct RmId { __device__ __forceinline__ int operator()(int n) const { return n; } };
struct RmWin {
    __device__ __forceinline__ int operator()(int n) const {
        if (n < 1536) { const int x = n - 512, ch = x & 511, gate = x >> 9; return 2048 + (ch >> 2) * 8 + gate * 4 + (ch & 3); }
        if (n < 3584) { const int x = n - 1536, blk = x >> 6, d = x & 63; return 3072 + blk * 64 + ((d & 31) >> 2) * 8 + (d >> 5) * 4 + (d & 3); }
        return 1024 + (n - 3584);
    }
};

__device__ __forceinline__ void phase_prep(const Params& p, LAS unsigned char* lds) {
    const int tid = opaque_tid(), G = gridDim.x;
    unsigned char* ws = p.ws;
    LAS float* scr = (LAS float*)lds;
    constexpr int I_ADA = 768, I_TRL = 512 + 256 + 1024 + 1024, I_TR = 2 * I_TRL;
    constexpr int I_WINF = 640, I_WPW = 128, I_DFT = 0, I_DFTC = 32, I_ROPE = 16, I_MT = 128, I_BO = 32, I_MISC = 1;
    constexpr int NIT = I_ADA + I_TR + I_WINF + I_WPW + I_DFT + I_DFTC + I_ROPE + I_MT + I_BO + I_MISC;
    bool sc_ready = false;
    for (int it = blockIdx.x; it < NIT; it += G) {
        int r = it < I_MT + I_BO + I_MISC ? NIT - (I_MT + I_BO + I_MISC) + it : it - (I_MT + I_BO + I_MISC);
        if (r < I_ADA) {
            const int l = r / 384, n0 = (r % 384) * 32;
            LAS float* sc = scr;
            if (!sc_ready) { for (int i = tid; i < 5 * 2048; i += NTHR) { const int bi = i >> 11, k = i & 2047; const float v = bi < 4 ? p.c[bi * 2048 + k] : p.c_ctx[k]; sc[i] = v * fsigmoid(v); } sc_ready = true; }
            __syncthreads();
            const int kg = tid >> 3, c4 = (tid & 7) * 4;
            f32x4 a[5];
#pragma unroll
            for (int bi = 0; bi < 5; ++bi) a[bi] = (f32x4){0.f, 0.f, 0.f, 0.f};
            const float* W = p.w_ada + (size_t)l * 2048 * 12288 + n0 + c4;
#pragma unroll 1
            for (int i0 = 0; i0 < 32; i0 += 8) {
                f32x4 w[8];
#pragma unroll
                for (int u = 0; u < 8; ++u) w[u] = *(const f32x4*)(W + (size_t)(kg + 64 * (i0 + u)) * 12288);
#pragma unroll
                for (int u = 0; u < 8; ++u) { const int k = kg + 64 * (i0 + u);
#pragma unroll
                    for (int bi = 0; bi < 5; ++bi) a[bi] += w[u] * sc[bi * 2048 + k]; } }
            LAS float* red = scr + 5 * 2048;
#pragma unroll
            for (int bi = 0; bi < 5; ++bi)
#pragma unroll
                for (int j = 0; j < 4; ++j) red[(kg * 8 + (tid & 7)) * 20 + bi * 4 + j] = a[bi][j];
            __syncthreads();
            if (tid < 160) { const int cl = tid / 20, q = tid % 20; float s = 0.f; for (int g = 0; g < 64; ++g) s += red[(g * 8 + cl) * 20 + q];
                const int bi = q >> 2, j = q & 3, n = n0 + cl * 4 + j;
                ((float*)(ws + O_MOD))[(size_t)(l * 5 + bi) * 12288 + n] = s + p.b_ada[l * 12288 + n]; }
            __syncthreads();
            continue;
        }
        r -= I_ADA; sc_ready = false;
        if (r < I_TR) {
            const int l = r / I_TRL; int q = r % I_TRL;
            if (l == 1 && (q < 512 || q >= 768)) continue;
            if (q < 512) { const int kt = q >> 6, ntile = q & 63; tr_tile(p.w_in + (size_t)l * 2048 * INC, INC, kt * 256, 512 + ntile * 64, (bf16_t*)(ws + O_WINT + l * SZ_WINT), 2048, kt * 256, RmWin(), scr); continue; }
            q -= 512;
            if (q < 256) { const int kt = q >> 5, ntile = q & 31; const int k0 = kt * 256;
                if (k0 >= 512 && k0 < 1024) tr_tile(p.w_out + (size_t)l * 2048 * 2048, 2048, k0, ntile * 64, (bf16_t*)(ws + O_WTMP + l * SZ_WTMP), 512, k0 - 512, RmId(), scr);
                else tr_tile(p.w_out + (size_t)l * 2048 * 2048, 2048, k0, ntile * 64, (bf16_t*)(ws + O_WOUTF + l * SZ_WOUTF), 2048, k0, RmId(), scr);
                continue; }
            q -= 256;
            if (q < 1024) { const int kt = q >> 7, ntile = q & 127; tr_tile(p.w_mlp_in + (size_t)l * 2048 * 8192, 8192, kt * 256, ntile * 64, (bf16_t*)(ws + O_WMI + l * SZ_WMI), 2048, kt * 256, RmId(), scr); continue; }
            q -= 1024;
            { const int kt = q >> 5, ntile = q & 31; tr_tile(p.w_mlp_out + (size_t)l * 8192 * 2048, 2048, kt * 256, ntile * 64, (bf16_t*)(ws + O_WMO + l * SZ_WMO), 8192, kt * 256, RmId(), scr); continue; }
        }
        r -= I_TR;
        if (r < I_WINF) {
            const size_t e0 = (size_t)r * 4096 + (size_t)tid * 8; const int l = (int)(e0 / (2048 * 640)); const size_t x = e0 % (2048 * 640); const int k = (int)(x / 640), c = (int)(x % 640);
            u32x4 o = (u32x4){0u, 0u, 0u, 0u};
            if (c < 512) { const float* s = p.w_in + ((size_t)l * 2048 + k) * INC + c; const f32x4 a = *(const f32x4*)s, b = *(const f32x4*)(s + 4);
                o.x = pk2(a[0], a[1]); o.y = pk2(a[2], a[3]); o.z = pk2(b[0], b[1]); o.w = pk2(b[2], b[3]); }
            *(u32x4*)((bf16_t*)(ws + O_WINF) + e0) = o; continue;
        }
        r -= I_WINF;
        if (r < I_WPW) { const size_t e0 = (size_t)r * 4096 + (size_t)tid * 8; const float* s = p.w_conv_pw + e0; const f32x4 a = *(const f32x4*)s, b = *(const f32x4*)(s + 4);
            u32x4 o; o.x = pk2(a[0], a[1]); o.y = pk2(a[2], a[3]); o.z = pk2(b[0], b[1]); o.w = pk2(b[2], b[3]); *(u32x4*)((bf16_t*)(ws + O_WPW) + e0) = o; continue; }
        r -= I_WPW;
        if (r < I_DFT) {
            const size_t e0 = (size_t)r * 4096 + (size_t)tid * 8; const int j = (int)(e0 >> 12), k0 = (int)(e0 & 4095);
            float v[8];
#pragma unroll
            for (int i = 0; i < 8; ++i) { const int k = k0 + i, kk = k & 2047; const float rev = (float)((j * kk) & 2047) * (1.0f / 2048.0f);
                v[i] = (k < 2048 ? cos_rev(rev) : -sin_rev(rev)) * 0.02209708691207961f; }
            u32x4 o; o.x = pk2(v[0], v[1]); o.y = pk2(v[2], v[3]); o.z = pk2(v[4], v[5]); o.w = pk2(v[6], v[7]); *(u32x4*)((bf16_t*)(ws + O_DFT) + e0) = o; continue;
        }
        r -= I_DFT;
        if (r < I_DFTC) {
            const size_t e0 = (size_t)r * 4096 + (size_t)tid * 8; const int j = (int)(e0 >> 9), k0 = (int)(e0 & 511);
            float v[8];
#pragma unroll
            for (int i = 0; i < 8; ++i) { const int k = k0 + i, kk = k & 255; const float rev = (float)((j * kk) & 255) * (1.0f / 256.0f);
                v[i] = (k < 256 ? cos_rev(rev) : -sin_rev(rev)) * 0.0625f; }
            u32x4 o; o.x = pk2(v[0], v[1]); o.y = pk2(v[2], v[3]); o.z = pk2(v[4], v[5]); o.w = pk2(v[6], v[7]); *(u32x4*)((bf16_t*)(ws + O_DFTC) + e0) = o; continue;
        }
        r -= I_DFTC;
        if (r < I_ROPE) {
#pragma unroll
            for (int i = 0; i < 8; ++i) { const int e = r * 4096 + i * 512 + tid, pos = e >> 5, f = e & 31;
                const float inv = exp2f(-(float)(f & 15) * (13.287712379549449f / 16.0f));
                const float ang = (float)(f < 16 ? (pos >> 6) : (pos & 63)) * inv;
                float rev = ang * 0.15915494309189535f; rev -= floorf(rev);
                float* o = (float*)(ws + O_ROPE) + (size_t)pos * 64 + f; o[0] = cos_rev(rev); o[32] = sin_rev(rev); }
            continue;
        }
        r -= I_ROPE;
        if (r < I_MT) {
            const int l = r >> 6, g = (r >> 4) & 3, cs = (r >> 3) & 1, cq = r & 7;
            const float* Wf = p.w_fourier + (size_t)(l * 4 + g) * 128 * 128;
            LAS float* sw = scr;
            LAS float* tb = scr + 128 * 128;
            for (int i = tid; i < 128 * 128; i += NTHR) sw[i] = Wf[i];
            if (tid < 128) { const float rev = (float)tid * (1.0f / 128.0f); tb[tid] = (cs ? sin_rev(rev) : cos_rev(rev)) * 0.08838834764831845f; }
            __syncthreads();
            bf16_t* dst = (bf16_t*)(ws + O_MTP + l * SZ_MTP) + (size_t)(g * 256 + cs * 128) * 256;
            for (int o = tid; o < 16 * 128; o += NTHR) { const int e = o & 127, c = cq * 16 + (o >> 7); float s = 0.f;
#pragma unroll 8
                for (int c2 = 0; c2 < 128; ++c2) s += tb[(c * c2) & 127] * sw[c2 * 128 + e];
                dst[(size_t)e * 256 + c] = (bf16_t)(pk2(s, 0.f) & 0xffffu); dst[(size_t)e * 256 + 128 + c] = 0; }
            __syncthreads();
            continue;
        }
        r -= I_MT;
        if (r < I_BO) {
            const int l = r >> 4, n = (r & 15) * 128 + (tid & 127), jq = tid >> 7;
            const float* W = p.w_out + ((size_t)l * 2048 + 512 + jq * 128) * 2048 + n; const float* bp = p.b_conv_pw + l * 512 + jq * 128;
            float s = 0.f;
#pragma unroll 1
            for (int j0 = 0; j0 < 128; j0 += 16) { float w[16];
#pragma unroll
                for (int u = 0; u < 16; ++u) w[u] = W[(size_t)(j0 + u) * 2048];
#pragma unroll
                for (int u = 0; u < 16; ++u) s += bp[j0 + u] * w[u]; }
            scr[tid] = s;
            __syncthreads();
            if (tid < 128) ((float*)(ws + O_BO))[l * 2048 + n] = (scr[tid] + scr[tid + 128]) + (scr[tid + 256] + scr[tid + 384]);
            __syncthreads();
            continue;
        }
        r -= I_BO;
        {
            if (tid < 128) { const int l = tid >> 6, i = tid & 63; const float a = wave_sum(p.lq1[l * 64 + i] * p.lk1[l * 64 + i]), b = wave_sum(p.lq2[l * 64 + i] * p.lk2[l * 64 + i]);
                if (i == 0) ((float*)(ws + O_MISC))[l] = __expf(a) - __expf(b) + (0.8f - 0.6f * __expf(-0.3f * (float)l)); }
            if (tid >= 128 && tid < 144) ((unsigned*)(ws + O_MISC))[16 + (tid - 128) * 8] = 0u;
            if (tid >= 256 && tid < 384) ((unsigned*)(ws + O_KMAX))[tid - 256] = 0u;
        }
    }
}

struct RowArgs {
    int mode; bool hasH; int nrows;
    const float* xlat; const float* xctx; float* olat; float* octx;
    const bf16_t* Y; const bf16_t* YP; const float* bias;
    const float* gpost; const float* gn; const float* mod;
    const float* modn; int gate_off, sh_off, sc_off; bf16_t* H;
    const bf16_t* x16; bf16_t* o16; bool in16, out16;
};
__device__ __forceinline__ void phase_rows(const RowArgs& a) {
    const int tid = opaque_tid(), lane = tid & 63, wid = tid >> 6, gw = blockIdx.x * 8 + wid, NW = gridDim.x * 8;
    for (int r = gw; r < a.nrows; r += NW) {
        const bool lat = r < NLAT; const int bi = lat ? (r >> 11) : 4;
        int l4 = lane * 4; asm volatile("" : "+v"(l4));
        const float* xr = (lat ? a.xlat + (size_t)r * D : a.xctx + (size_t)(r - NLAT) * D) + l4;
        f32x4 x[8];
        if (a.in16) { u32x2 w[8];
#pragma unroll
            for (int j = 0; j < 8; ++j) w[j] = *(const u32x2*)(a.x16 + (size_t)r * D + l4 + 256 * j);
#pragma unroll
            for (int j = 0; j < 8; ++j) x[j] = (f32x4){bf_lo(w[j].x), bf_hi(w[j].x), bf_lo(w[j].y), bf_hi(w[j].y)};
        } else {
#pragma unroll
            for (int j = 0; j < 8; ++j) x[j] = *(const f32x4*)(xr + 256 * j);
        }
        if (a.mode == 1) {
            f32x4 y[8];
            if (lat) {
                u32x2 w[8];
#pragma unroll
                for (int j = 0; j < 8; ++j) w[j] = *(const u32x2*)(a.Y + (size_t)r * D + l4 + 256 * j);
#pragma unroll
                for (int j = 0; j < 8; ++j) y[j] = (f32x4){bf_lo(w[j].x), bf_hi(w[j].x), bf_lo(w[j].y), bf_hi(w[j].y)};
            } else {
#pragma unroll
                for (int j = 0; j < 8; ++j) y[j] = (f32x4){0.f, 0.f, 0.f, 0.f};
#pragma unroll 1
                for (int q = 0; q < 8; q += 4) { const bf16_t* yp = a.YP + (size_t)q * NCTX * D + (size_t)(r - NLAT) * D + l4;
                    u32x2 t[4][8];
#pragma unroll
                    for (int qq = 0; qq < 4; ++qq)
#pragma unroll
                        for (int j = 0; j < 8; ++j) t[qq][j] = *(const u32x2*)(yp + (size_t)qq * NCTX * D + 256 * j);
#pragma unroll
                    for (int qq = 0; qq < 4; ++qq)
#pragma unroll
                        for (int j = 0; j < 8; ++j) y[j] += (f32x4){bf_lo(t[qq][j].x), bf_hi(t[qq][j].x), bf_lo(t[qq][j].y), bf_hi(t[qq][j].y)}; }
            }
            if (a.bias) {
                f32x4 bv[8];
#pragma unroll
                for (int j = 0; j < 8; ++j) bv[j] = *(const f32x4*)(a.bias + l4 + 256 * j);
#pragma unroll
                for (int j = 0; j < 8; ++j) y[j] += bv[j]; }
            const float* gate = a.mod + (size_t)bi * 12288 + a.gate_off + l4;
            f32x4 g[8], gp[8];
#pragma unroll
            for (int j = 0; j < 8; ++j) { g[j] = *(const f32x4*)(gate + 256 * j); gp[j] = *(const f32x4*)(a.gpost + l4 + 256 * j); }
            float ss = 0.f;
#pragma unroll
            for (int j = 0; j < 8; ++j) ss += (y[j][0] * y[j][0] + y[j][1] * y[j][1]) + (y[j][2] * y[j][2] + y[j][3] * y[j][3]);
            const float rstd = rsqrtf(wave_sum(ss) * (1.0f / D) + EPS);
#pragma unroll
            for (int j = 0; j < 8; ++j) x[j] = x[j] + g[j] * (y[j] * rstd * gp[j]);
        }
        if (a.hasH) {
            const float* sh = a.modn + (size_t)bi * 12288 + a.sh_off + l4; const float* sc = a.modn + (size_t)bi * 12288 + a.sc_off + l4;
            f32x4 gn[8], s1[8], s2[8];
#pragma unroll
            for (int j = 0; j < 8; ++j) { gn[j] = *(const f32x4*)(a.gn + l4 + 256 * j); s1[j] = *(const f32x4*)(sh + 256 * j); s2[j] = *(const f32x4*)(sc + 256 * j); }
            float ss = 0.f;
#pragma unroll
            for (int j = 0; j < 8; ++j) ss += (x[j][0] * x[j][0] + x[j][1] * x[j][1]) + (x[j][2] * x[j][2] + x[j][3] * x[j][3]);
            const float rstd = rsqrtf(wave_sum(ss) * (1.0f / D) + EPS);
            u32x2 w[8];
#pragma unroll
            for (int j = 0; j < 8; ++j) { const f32x4 h = (x[j] * rstd * gn[j]) * (s2[j] + 1.0f) + s1[j]; w[j].x = pk2(h[0], h[1]); w[j].y = pk2(h[2], h[3]); }
#pragma unroll
            for (int j = 0; j < 8; ++j) *(u32x2*)(a.H + (size_t)r * D + l4 + 256 * j) = w[j];
        }
        if (a.mode == 1) {
            if (a.out16) {
#pragma unroll
                for (int j = 0; j < 8; ++j) { u32x2 w; w.x = pk2(x[j][0], x[j][1]); w.y = pk2(x[j][2], x[j][3]); *(u32x2*)(a.o16 + (size_t)r * D + l4 + 256 * j) = w; }
            } else {
                float* orow = (lat ? a.olat + (size_t)r * D : a.octx + (size_t)(r - NLAT) * D) + l4;
#pragma unroll
                for (int j = 0; j < 8; ++j) *(f32x4*)(orow + 256 * j) = x[j];
            }
        }
    }
}

__device__ __forceinline__ void attn_item(const Params& p, LAS unsigned char* lds, int l, int b, int h, int qb, bool isctx) {
    unsigned char* ws = p.ws;
    const int tid = opaque_tid(), wid = __builtin_amdgcn_readfirstlane(tid >> 6), lane = tid & 63, mm = wid >> 2, rg = wid & 3, qi = lane & 31, hh = lane >> 5;
    const int nt = isctx ? 4 : 36;
    const int qrow = (isctx ? NLAT + b * 256 : b * 2048) + qb * 128 + rg * 32 + qi;
    bf16x8 Bq[4];
    { const bf16_t* Q = (const bf16_t*)(ws + O_Q) + (size_t)qrow * 1024 + h * 128 + mm * 64 + hh * 8;
#pragma unroll
        for (int ks = 0; ks < 4; ++ks) Bq[ks] = *(const bf16x8*)(Q + ks * 16); }
    const char* Kb = (const char*)(ws + O_KK) + (size_t)((b * NH + h) * 2) * LK * 128;
    const char* Vb = (const char*)(ws + O_VT) + (size_t)(b * NH + h) * 128 * LK * 2;
    const int skey = tid >> 3, sch = tid & 7;
    const unsigned koff = (unsigned)(skey * 128 + sch * 16);
    const char* Kb1 = Kb + (size_t)LK * 128;
    const int kdst = skey * 128 + ((sch ^ ((skey >> 1) & 7)) * 16);
    const int e0s = skey, e1s = skey + 64;
    const unsigned voff = (unsigned)(e0s * (LK * 2) + sch * 16); const char* Vb1 = Vb + (size_t)64 * (LK * 2);
    const int vsw = (skey >> 1) & 7;
    const int vdA = (((sch & 6)) ^ vsw) * 16 + (sch & 1) * 8, vdB = (((sch & 6) + 1) ^ vsw) * 16 + (sch & 1) * 8;
    const int vdst0 = e0s * 128, vdst1 = e1s * 128;
    u32x4 rk0, rk1, rv0, rv1;
#define ATT_LOAD(t) do { rk0 = *(const u32x4*)(Kb + (koff + (unsigned)(t) * 8192u)); rk1 = *(const u32x4*)(Kb1 + (koff + (unsigned)(t) * 8192u)); \
        rv0 = *(const u32x4*)(Vb + (voff + (unsigned)(t) * 128u)); rv1 = *(const u32x4*)(Vb1 + (voff + (unsigned)(t) * 128u)); } while (0)
#define ATT_STORE(buf) do { *(LAS u32x4*)(lds + (buf) * 16384 + kdst) = rk0; *(LAS u32x4*)(lds + (buf) * 16384 + 8192 + kdst) = rk1; \
        *(LAS u32x2*)(lds + 32768 + (buf) * 16384 + vdst0 + vdA) = (u32x2){rv0.x, rv0.y}; *(LAS u32x2*)(lds + 32768 + (buf) * 16384 + vdst0 + vdB) = (u32x2){rv0.z, rv0.w}; \
        *(LAS u32x2*)(lds + 32768 + (buf) * 16384 + vdst1 + vdA) = (u32x2){rv1.x, rv1.y}; *(LAS u32x2*)(lds + 32768 + (buf) * 16384 + vdst1 + vdB) = (u32x2){rv1.z, rv1.w}; } while (0)
    f32x16 oacc[4];
#pragma unroll
    for (int et = 0; et < 4; ++et)
#pragma unroll
        for (int r = 0; r < 16; ++r) oacc[et][r] = 0.f;
    float lsum = 0.f, nmref;
    { float qs = 0.f;
#pragma unroll
        for (int ks = 0; ks < 4; ++ks) { const u32x4 w = __builtin_bit_cast(u32x4, Bq[ks]);
#pragma unroll
            for (int j = 0; j < 4; ++j) { const float a = bf_lo(w[j]), c = bf_hi(w[j]); qs += a * a + c * c; } }
        qs += __shfl_xor(qs, 32);
        const float k2 = __uint_as_float(((const unsigned*)(ws + O_KMAX))[l * 64 + b * 16 + h * 2 + mm]);
        nmref = -(sqrtf(qs * k2) * 1.02f + 1e-6f); }
    const int ksw = (qi >> 1) & 7;
    const int kread = mm * 8192 + qi * 128;
    const int vread = 32768 + qi * 128;
    ATT_LOAD(0);
    const u32x4 rk2 = *(const u32x4*)(Kb + (koff + 8192u)), rk3 = *(const u32x4*)(Kb1 + (koff + 8192u));
    { *(LAS u32x4*)(lds + kdst) = rk0; *(LAS u32x4*)(lds + 8192 + kdst) = rk1;
      *(LAS u32x2*)(lds + 32768 + 16384 + vdst0 + vdA) = (u32x2){rv0.x, rv0.y}; *(LAS u32x2*)(lds + 32768 + 16384 + vdst0 + vdB) = (u32x2){rv0.z, rv0.w};
      *(LAS u32x2*)(lds + 32768 + 16384 + vdst1 + vdA) = (u32x2){rv1.x, rv1.y}; *(LAS u32x2*)(lds + 32768 + 16384 + vdst1 + vdB) = (u32x2){rv1.z, rv1.w}; }
    { *(LAS u32x4*)(lds + 16384 + kdst) = rk2; *(LAS u32x4*)(lds + 16384 + 8192 + kdst) = rk3; }
    __syncthreads();
    f32x16 s0, s1;
#pragma unroll
    for (int r = 0; r < 16; ++r) { s0[r] = nmref; s1[r] = nmref; }
#pragma unroll
    for (int ks = 0; ks < 4; ++ks) {
        const int co = ((2 * ks + hh) ^ ksw) * 16;
        const bf16x8 a0 = *(const LAS bf16x8*)(lds + kread + co);
        const bf16x8 a1 = *(const LAS bf16x8*)(lds + kread + 4096 + co);
        s0 = __builtin_amdgcn_mfma_f32_32x32x16_bf16(a0, Bq[ks], s0, 0, 0, 0);
        s1 = __builtin_amdgcn_mfma_f32_32x32x16_bf16(a1, Bq[ks], s1, 0, 0, 0);
    }
    bf16x8 Pf[4];
#pragma unroll
    for (int i = 0; i < 4; ++i) Pf[i] = (bf16x8){0, 0, 0, 0, 0, 0, 0, 0};
    for (int t = 0; t < nt; ++t) {
        const int bk = ((t + 1) & 1) * 16384, bv = ((t + 1) & 1) * 16384;
        rv0 = *(const u32x4*)(Vb + (voff + (unsigned)t * 128u)); rv1 = *(const u32x4*)(Vb1 + (voff + (unsigned)t * 128u));
        if (t + 2 < nt) { rk0 = *(const u32x4*)(Kb + (koff + (unsigned)(t + 2) * 8192u)); rk1 = *(const u32x4*)(Kb1 + (koff + (unsigned)(t + 2) * 8192u)); }
#pragma unroll
        for (int s4 = 0; s4 < 4; ++s4) {
            const int c0 = ((2 * s4 + hh) ^ ksw) * 16;
#pragma unroll
            for (int et = 0; et < 4; ++et) {
                const bf16x8 vv = *(const LAS bf16x8*)(lds + bv + vread + et * 4096 + c0);
                oacc[et] = __builtin_amdgcn_mfma_f32_32x32x16_bf16(vv, Pf[s4], oacc[et], 0, 0, 0);
            }
        }
        f32x16 n0, n1;
#pragma unroll
        for (int r = 0; r < 16; ++r) { n0[r] = nmref; n1[r] = nmref; }
#pragma unroll
        for (int ks = 0; ks < 4; ++ks) {
            const int co = ((2 * ks + hh) ^ ksw) * 16;
            const bf16x8 a0 = *(const LAS bf16x8*)(lds + bk + kread + co);
            const bf16x8 a1 = *(const LAS bf16x8*)(lds + bk + kread + 4096 + co);
            n0 = __builtin_amdgcn_mfma_f32_32x32x16_bf16(a0, Bq[ks], n0, 0, 0, 0);
            n1 = __builtin_amdgcn_mfma_f32_32x32x16_bf16(a1, Bq[ks], n1, 0, 0, 0);
        }
        float ps = 0.f;
#pragma unroll
        for (int r = 0; r < 16; ++r) { s0[r] = __builtin_amdgcn_exp2f(s0[r]); s1[r] = __builtin_amdgcn_exp2f(s1[r]); ps += s0[r] + s1[r]; }
        lsum += ps;
        bf16x8 Pn[4];
#pragma unroll
        for (int s = 0; s < 2; ++s) {
            u32x4 w0, w1;
            w0.x = pk2(s0[8 * s + 0], s0[8 * s + 1]); w0.y = pk2(s0[8 * s + 2], s0[8 * s + 3]); w0.z = pk2(s0[8 * s + 4], s0[8 * s + 5]); w0.w = pk2(s0[8 * s + 6], s0[8 * s + 7]);
            w1.x = pk2(s1[8 * s + 0], s1[8 * s + 1]); w1.y = pk2(s1[8 * s + 2], s1[8 * s + 3]); w1.z = pk2(s1[8 * s + 4], s1[8 * s + 5]); w1.w = pk2(s1[8 * s + 6], s1[8 * s + 7]);
            Pn[s] = __builtin_bit_cast(bf16x8, w0); Pn[2 + s] = __builtin_bit_cast(bf16x8, w1);
        }
#pragma unroll
        for (int i = 0; i < 4; ++i) Pf[i] = Pn[i];
        s0 = n0; s1 = n1;
#pragma unroll
        for (int i = 0; i < 24; ++i) { __builtin_amdgcn_sched_group_barrier(0x008, 1, 0); __builtin_amdgcn_sched_group_barrier(0x002, 7, 0); }
        { const int bo = (t & 1) * 16384;
          *(LAS u32x2*)(lds + 32768 + bo + vdst0 + vdA) = (u32x2){rv0.x, rv0.y}; *(LAS u32x2*)(lds + 32768 + bo + vdst0 + vdB) = (u32x2){rv0.z, rv0.w};
          *(LAS u32x2*)(lds + 32768 + bo + vdst1 + vdA) = (u32x2){rv1.x, rv1.y}; *(LAS u32x2*)(lds + 32768 + bo + vdst1 + vdB) = (u32x2){rv1.z, rv1.w};
          if (t + 2 < nt) { *(LAS u32x4*)(lds + bo + kdst) = rk0; *(LAS u32x4*)(lds + bo + 8192 + kdst) = rk1; } }
        __syncthreads();
    }
    {
        const int bv = ((nt - 1) & 1) * 16384;
#pragma unroll
        for (int s4 = 0; s4 < 4; ++s4) {
            const int c0 = ((2 * s4 + hh) ^ ksw) * 16;
#pragma unroll
            for (int et = 0; et < 4; ++et) {
                const bf16x8 vv = *(const LAS bf16x8*)(lds + bv + vread + et * 4096 + c0);
                oacc[et] = __builtin_amdgcn_mfma_f32_32x32x16_bf16(vv, Pf[s4], oacc[et], 0, 0, 0);
            }
        }
    }
#undef ATT_LOAD
#undef ATT_STORE
    const float ltot = lsum + __shfl_xor(lsum, 32), inv = 1.0f / ltot;
    LAS float* comb = (LAS float*)(lds + 65536);
    if (mm == 1) {
#pragma unroll
        for (int et = 0; et < 4; ++et)
#pragma unroll
            for (int r = 0; r < 16; ++r) comb[(rg * 64 + et * 16 + r) * 64 + lane] = oacc[et][r] * inv;
    }
    __syncthreads();
    if (mm == 0) {
        const float lam = ((const float*)(ws + O_MISC))[l];
        const float post = 1.0f - (0.8f - 0.6f * __expf(-0.3f * (float)l));
        float ss = 0.f;
        float cv[4][16];
#pragma unroll
        for (int et = 0; et < 4; ++et)
#pragma unroll
            for (int r = 0; r < 16; ++r) cv[et][r] = comb[(rg * 64 + et * 16 + r) * 64 + lane];
#pragma unroll
        for (int et = 0; et < 4; ++et)
#pragma unroll
            for (int r = 0; r < 16; ++r) { const float o = oacc[et][r] * inv - lam * cv[et][r]; oacc[et][r] = o; ss += o * o; }
        ss += __shfl_xor(ss, 32);
        const float rstd = rsqrtf(ss * (1.0f / 128.0f) + EPS) * post;
        const float* gs = p.g_subln + l * 128;
        bf16_t* dst = (bf16_t*)(ws + O_CAT) + (size_t)qrow * D + 1024 + h * 128;
        f32x4 g[4][4];
#pragma unroll
        for (int et = 0; et < 4; ++et)
#pragma unroll
            for (int rq = 0; rq < 4; ++rq) g[et][rq] = *(const f32x4*)(gs + 32 * et + 8 * rq + 4 * hh);
        u32x2 w[4][4];
#pragma unroll
        for (int et = 0; et < 4; ++et)
#pragma unroll
            for (int rq = 0; rq < 4; ++rq) { w[et][rq].x = pk2(oacc[et][4 * rq] * rstd * g[et][rq][0], oacc[et][4 * rq + 1] * rstd * g[et][rq][1]);
                w[et][rq].y = pk2(oacc[et][4 * rq + 2] * rstd * g[et][rq][2], oacc[et][4 * rq + 3] * rstd * g[et][rq][3]); }
#pragma unroll
        for (int et = 0; et < 4; ++et)
#pragma unroll
            for (int rq = 0; rq < 4; ++rq) *(u32x2*)(dst + 32 * et + 8 * rq + 4 * hh) = w[et][rq];
    }
    __syncthreads();
}

__device__ __forceinline__ void conv_item(const Params& p, LAS unsigned char* lds, int l, int seq, int tile) {
    unsigned char* ws = p.ws;
    const int tid = opaque_tid(), wid = tid >> 6, lane = tid & 63;
    const bool lat = seq < 4; const int L = lat ? SEQ : CTXL; const int row0 = lat ? seq * SEQ : NLAT + (seq - 4) * CTXL; const int pos0 = tile * 32;
    LAS unsigned* zs = (LAS unsigned*)lds;
    LAS float* co = (LAS float*)(lds + 63488);
    const unsigned* Z = (const unsigned*)(ws + O_Z);
    for (int i = tid; i < 62 * 64; i += NTHR) { const int rr = i >> 6, c4 = (i & 63) * 4; const int pos = pos0 - 15 + rr;
        u32x4 v = (u32x4){0u, 0u, 0u, 0u};
        if (pos >= 0 && pos < L) v = *(const u32x4*)(Z + (size_t)(row0 + pos) * 256 + c4);
        *(LAS u32x4*)(zs + rr * 256 + c4) = v; }
    const int cp = tid & 255, th = tid >> 8;
    float w0[31], w1[31];
    const float* wd = p.w_dw + (size_t)l * 31 * 512 + 2 * cp;
#pragma unroll
    for (int j = 0; j < 31; ++j) { w0[j] = wd[j * 512]; w1[j] = wd[j * 512 + 1]; }
    const float b0 = p.b_dw[l * 512 + 2 * cp], b1 = p.b_dw[l * 512 + 2 * cp + 1];
    __syncthreads();
    for (int i = 0; i < 16; ++i) { const int tt = th * 16 + i; float a0 = b0, a1 = b1;
#pragma unroll
        for (int j = 0; j < 31; ++j) { const unsigned v = zs[(tt + j) * 256 + cp]; a0 += w0[j] * bf_lo(v); a1 += w1[j] * bf_hi(v); }
        co[tt * 512 + 2 * cp] = a0; co[tt * 512 + 2 * cp + 1] = a1; }
    __syncthreads();
    const float* gl = p.g_conv_ln + l * 512 + lane * 8; const float* bl = p.b_conv_ln + l * 512 + lane * 8;
    for (int q = 0; q < 4; ++q) { const int tt = wid * 4 + q;
        float v[8]; float s = 0.f;
#pragma unroll
        for (int j = 0; j < 8; ++j) { v[j] = co[tt * 512 + lane * 8 + j]; s += v[j]; }
        const float mean = wave_sum(s) * (1.0f / 512.0f); float s2 = 0.f;
#pragma unroll
        for (int j = 0; j < 8; ++j) { v[j] -= mean; s2 += v[j] * v[j]; }
        const float rstd = rsqrtf(wave_sum(s2) * (1.0f / 512.0f) + EPS);
#pragma unroll
        for (int j = 0; j < 8; ++j) { const float y = v[j] * rstd * gl[j] + bl[j]; v[j] = y * fsigmoid(y); }
        u32x4 o; o.x = pk2(v[0], v[1]); o.y = pk2(v[2], v[3]); o.z = pk2(v[4], v[5]); o.w = pk2(v[6], v[7]);
        *(u32x4*)((bf16_t*)(ws + O_CAT) + (size_t)(row0 + pos0 + tt) * D + 512 + lane * 8) = o; }
    __syncthreads();
}


typedef float f32x2 __attribute__((ext_vector_type(2)));
__device__ __forceinline__ f32x2 cmul(f32x2 a, f32x2 w) { return (f32x2){a.x * w.x - a.y * w.y, a.x * w.y + a.y * w.x}; }
__device__ __forceinline__ f32x2 tw_rev(float f) { return (f32x2){cos_rev(f), -sin_rev(f)}; }
__device__ __forceinline__ void fft4(f32x2& a0, f32x2& a1, f32x2& a2, f32x2& a3) {
    const f32x2 t0 = a0 + a2, t1 = a0 - a2, t2 = a1 + a3, d = a1 - a3; const f32x2 t3 = (f32x2){d.y, -d.x};
    a0 = t0 + t2; a1 = t1 + t3; a2 = t0 - t2; a3 = t1 - t3;
}
__device__ __forceinline__ void fft16(f32x2 (&v)[16], f32x2 (&o)[16]) {
    constexpr float C1 = 0.9238795325112867f, S1 = 0.3826834323650898f, C2 = 0.7071067811865476f;
#pragma unroll
    for (int n1 = 0; n1 < 4; ++n1) fft4(v[n1], v[n1 + 4], v[n1 + 8], v[n1 + 12]);
    v[5] = cmul(v[5], (f32x2){C1, -S1}); v[9] = cmul(v[9], (f32x2){C2, -C2}); v[13] = cmul(v[13], (f32x2){S1, -C1});
    v[6] = cmul(v[6], (f32x2){C2, -C2}); v[10] = (f32x2){v[10].y, -v[10].x}; v[14] = cmul(v[14], (f32x2){-C2, -C2});
    v[7] = cmul(v[7], (f32x2){S1, -C1}); v[11] = cmul(v[11], (f32x2){-C2, -C2}); v[15] = cmul(v[15], (f32x2){-C1, S1});
#pragma unroll
    for (int p = 0; p < 4; ++p) { fft4(v[4 * p], v[4 * p + 1], v[4 * p + 2], v[4 * p + 3]);
        o[p] = v[4 * p]; o[4 + p] = v[4 * p + 1]; o[8 + p] = v[4 * p + 2]; o[12 + p] = v[4 * p + 3]; }
}
__device__ __forceinline__ void fft8(f32x2 (&v)[8], f32x2 (&o)[8]) {
    constexpr float C2 = 0.7071067811865476f;
    f32x2 s0 = v[0] + v[4], s1 = v[1] + v[5], s2 = v[2] + v[6], s3 = v[3] + v[7];
    f32x2 d0 = v[0] - v[4], d1 = cmul(v[1] - v[5], (f32x2){C2, -C2}), d2 = v[2] - v[6], d3 = cmul(v[3] - v[7], (f32x2){-C2, -C2});
    d2 = (f32x2){d2.y, -d2.x};
    fft4(s0, s1, s2, s3); fft4(d0, d1, d2, d3);
    o[0] = s0; o[2] = s1; o[4] = s2; o[6] = s3; o[1] = d0; o[3] = d1; o[5] = d2; o[7] = d3;
}
__device__ __forceinline__ void fft_item(const Params& p, LAS unsigned char* lds, int b, int n0) {
    unsigned char* ws = p.ws;
    const int tid = opaque_tid();
    constexpr int CS = 2176;
    LAS f32x2* Z = (LAS f32x2*)lds;
    const bf16_t* AB = (const bf16_t*)(ws + O_ABT);
#pragma unroll
    for (int i = 0; i < 2; ++i) { const int ch = tid + 512 * i, col = ch >> 8, pc = ch & 255;
        const bf16_t* src = AB + (size_t)(n0 + col) * 16384 + b * 4096 + pc * 8;
        const u32x4 a = *(const u32x4*)src, bb = *(const u32x4*)(src + 2048);
        LAS f32x2* d = Z + col * CS + pc * 8 + (pc >> 1);
#pragma unroll
        for (int q = 0; q < 4; ++q) { d[2 * q] = (f32x2){bf_lo(a[q]), -bf_lo(bb[q])}; d[2 * q + 1] = (f32x2){bf_hi(a[q]), -bf_hi(bb[q])}; } }
    __syncthreads();
    const int col = tid >> 7, j = tid & 127;
    LAS f32x2* Zc = Z + col * CS;
    f32x2 v[16], o[16];
#pragma unroll
    for (int r = 0; r < 16; ++r) { const int i = j + 128 * r; v[r] = Zc[i + (i >> 4)]; }
    fft16(v, o);
    __syncthreads();
#pragma unroll
    for (int q = 0; q < 16; ++q) Zc[17 * j + q] = o[q];
    __syncthreads();
    { const int k = j & 15;
#pragma unroll
        for (int r = 0; r < 16; ++r) { const int i = j + 128 * r; v[r] = Zc[i + (i >> 4)]; if (r) v[r] = cmul(v[r], tw_rev((float)(r * k) * (1.0f / 256.0f))); }
        fft16(v, o);
        __syncthreads();
        const int base = (j >> 4) * 256 + k;
#pragma unroll
        for (int q = 0; q < 16; ++q) { const int i = base + 16 * q; Zc[i + (i >> 4)] = o[q]; }
    }
    __syncthreads();
#pragma unroll
    for (int it = 0; it < 2; ++it) { const int jj = tid + 512 * it, c3 = jj >> 8, j3 = jj & 255;
        LAS f32x2* Z3 = Z + c3 * CS; f32x2 a[8], c[8];
#pragma unroll
        for (int r = 0; r < 8; ++r) { const int i = j3 + 256 * r; a[r] = Z3[i + (i >> 4)]; if (r) a[r] = cmul(a[r], tw_rev((float)(r * j3) * (1.0f / 2048.0f))); }
        fft8(a, c);
#pragma unroll
        for (int r = 0; r < 8; ++r) { const int i = j3 + 256 * r; Z3[i + (i >> 4)] = c[r]; } }
    __syncthreads();
    bf16_t* dst = (bf16_t*)(ws + O_CAT) + (size_t)b * SEQ * D + n0;
#pragma unroll
    for (int i = 0; i < 4; ++i) { const int pos = tid + 512 * i, sl = pos + (pos >> 4);
        constexpr float NRM = 0.02209708691207961f;
        u32x2 w; w.x = pk2(Z[sl].x * NRM, Z[CS + sl].x * NRM); w.y = pk2(Z[2 * CS + sl].x * NRM, Z[3 * CS + sl].x * NRM);
        *(u32x2*)(dst + (size_t)pos * D) = w; }
    __syncthreads();
}

__device__ __forceinline__ void phase_mix(const Params& p, LAS unsigned char* lds, LAS int* s_item, int l, int rep) {
    unsigned char* ws = p.ws;
    const bool cx = (l == 0);
    const int nA = 64, nFF = 64, nFC = cx ? 1 : 0, nAC = cx ? 8 : 0, nCV = cx ? 36 : 32;
    const int total = nA + nFF + nFC + nAC + nCV;
    const int xcc = (int)(xb_xcc_id() & 7u);
    unsigned live = 0xffu;
    for (int k = 0; k < 8; ++k) {
        const int x = (xcc + k) & 7;
        unsigned* ctr = (unsigned*)(ws + O_MISC) + 16 + (l * 8 + x) * 8;
        if (k == 1) {
            __syncthreads();
            if (threadIdx.x == 0) {
                const unsigned* cb = (const unsigned*)(ws + O_MISC) + 16 + (l * 8) * 8; unsigned c0, c1, c2, c3, c4, c5, c6, c7;
                asm volatile("global_load_dword %0, %8, off sc1\n\t" "global_load_dword %1, %8, off offset:32 sc1\n\t" "global_load_dword %2, %8, off offset:64 sc1\n\t"
                             "global_load_dword %3, %8, off offset:96 sc1\n\t" "global_load_dword %4, %8, off offset:128 sc1\n\t" "global_load_dword %5, %8, off offset:160 sc1\n\t"
                             "global_load_dword %6, %8, off offset:192 sc1\n\t" "global_load_dword %7, %8, off offset:224 sc1\n\t" "s_waitcnt vmcnt(0)"
                             : "=&v"(c0), "=&v"(c1), "=&v"(c2), "=&v"(c3), "=&v"(c4), "=&v"(c5), "=&v"(c6), "=&v"(c7) : "v"(cb) : "memory");
                const unsigned t = (unsigned)total;
                *s_item = (int)((c0 < t ? 1u : 0u) | (c1 < t ? 2u : 0u) | (c2 < t ? 4u : 0u) | (c3 < t ? 8u : 0u) | (c4 < t ? 16u : 0u) | (c5 < t ? 32u : 0u) | (c6 < t ? 64u : 0u) | (c7 < t ? 128u : 0u));
            }
            __syncthreads();
            live = (unsigned)*s_item;
        }
        if (!((live >> x) & 1u)) continue;
        for (;;) {
            __syncthreads();
            if (threadIdx.x == 0) *s_item = (int)atomicAdd(ctr, 1u);
            __syncthreads();
            int it = *s_item;
            if (it >= total) break;
            if (it < nA) { const int qb = it & 15, bh = (it >> 4) * 8 + x; attn_item(p, lds, l, bh >> 3, bh & 7, qb, false); continue; }
            it -= nA;
            if (it < nFF) { const int id = x * 64 + it; fft_item(p, lds, id >> 7, (id & 127) * 4); continue; }
            it -= nFF;
            if (it < nFC) { const int b = x >> 1, pn = x & 1;
                SchedOne S; S.u.a = (const char*)(ws + O_DFTC); S.u.b = (const char*)(ws + O_ABTC) + ((size_t)pn * 256 * 2048 + b * 512) * 2;
                S.u.nt = 8; S.u.kind = 0; S.u.pm = 0; S.u.pn = pn;
                EpiBf16<0> E; E.O = (bf16_t*)(ws + O_CAT) + (size_t)(NLAT + b * CTXL) * D; E.ldc = D;
                pg8::gemm_phase(lds, 512, 2048, S, E);
                continue; }
            it -= nFC;
            if (it < nAC) { const int qb = it & 1, bh = (it >> 1) * 8 + x; attn_item(p, lds, l, bh >> 3, bh & 7, qb, true); continue; }
            it -= nAC;
            { const int id = x * nCV + it; if (id < 256) conv_item(p, lds, l, id >> 6, id & 63); else { const int j = id - 256; conv_item(p, lds, l, 4 + (j >> 3), j & 7); } }
        }
    }
}

constexpr int NPH = 16;
__global__ void __launch_bounds__(512, 2) mega(Params p) {
    extern __shared__ __attribute__((aligned(16))) unsigned char shm[];
    LAS unsigned char* lds = (LAS unsigned char*)shm;
    unsigned char* ws = p.ws;
    const int G = gridDim.x, c = blockIdx.x;
    const float* MOD = (const float*)(ws + O_MOD);
    volatile LAS unsigned* xst = (volatile LAS unsigned*)(lds + LDS_BYTES + 16);
    if (threadIdx.x == 0) { xst[0] = 0u; xst[1] = 0u; }
    __syncthreads();
    const XcdBarrier xb = xcd_barrier_post((unsigned*)(ws + O_BAR), xst);
    if (p.ph_lo < 0) cg::this_grid().sync();
    for (int ph = p.ph_lo; ph < p.ph_hi; ++ph) {
        if (ph > p.ph_lo) xcd_barrier(xb);
        if (ph == 0) { phase_prep(p, lds); if (PROBE_DUP & 1) { __syncthreads(); phase_prep(p, lds); } continue; }
        if (ph == 1) {
            {
                for (int it = c; it < 64; it += G) { const int l = it >> 5, g = (it >> 3) & 3, pn = it & 7;
                    SchedOne S; S.u.a = (const char*)(ws + O_MTP + l * SZ_MTP) + (size_t)g * 256 * 256 * 2; S.u.b = (const char*)(ws + O_WINF + l * SZ_WINF) + ((size_t)pn * 256 * 640 + g * 128) * 2;
                    S.u.nt = 4; S.u.kind = 0; S.u.pm = g; S.u.pn = pn;
                    EpiBf16<0> E; E.O = (bf16_t*)(ws + O_WINT + l * SZ_WINT); E.ldc = 2048;
                    pg8::gemm_phase(lds, 256, 640, S, E); }
                for (int it = (G >= 96 ? (c >= 64 ? c - 64 : c + G - 64) : c); it < 32; it += G) { const int l = it >> 4, pm = (it >> 1) & 7, pn = it & 1;
                    SchedOne S; S.u.a = (const char*)(ws + O_WTMP + l * SZ_WTMP) + (size_t)pm * 256 * 512 * 2; S.u.b = (const char*)(ws + O_WPW + l * SZ_WPW) + (size_t)pn * 256 * 512 * 2;
                    S.u.nt = 8; S.u.kind = 0; S.u.pm = pm; S.u.pn = pn;
                    EpiBf16<0> E; E.O = (bf16_t*)(ws + O_WOUTF + l * SZ_WOUTF) + 512; E.ldc = 2048;
                    pg8::gemm_phase(lds, 512, 512, S, E); }
            }
            RowArgs a{}; a.mode = 0; a.hasH = true; a.nrows = NROW; a.xlat = p.x; a.xctx = p.ctx; a.gn = p.g_pre_mix; a.modn = MOD; a.sh_off = 0; a.sc_off = 2048; a.H = (bf16_t*)(ws + O_H);
            phase_rows(a); if (PROBE_DUP & 8) { phase_rows(a); phase_rows(a); for (int q = 0; q < 8; ++q) xcd_barrier(xb); } continue;
        }
        const int l = (ph - 2) / 7, sp = (ph - 2) % 7;
        for (int rep = 0; rep < (((PROBE_DUP & 2) && (sp == 0 || sp == 2 || sp == 4 || sp == 5)) ? 2 : 1); ++rep) {
        const bool cx = (l == 0);
        const float* xl = cx ? p.x : p.out; const float* xc = cx ? p.ctx : (const float*)(ws + O_CX);
        if (sp == 0) { SchedP2 S; S.H = (const char*)(ws + O_H); S.W = (const char*)(ws + O_WINT + l * SZ_WINT); S.G = G; S.c = c; EpiP2 E; E.ws = ws; E.layer = l; pg8::gemm_phase(lds, 2048, 2048, S, E);
            if (cx) {
                LAS float* scr = (LAS float*)lds; const bool std = (G == 256);
                if (!std || c >= 208)
                    for (int j = std ? c - 208 : c; j < 512; j += std ? 48 : G) { const int kt = j >> 6, ntile = j & 63;
                        tr_tile(p.w_in + (size_t)2048 * INC, INC, kt * 256, 512 + ntile * 64, (bf16_t*)(ws + O_WINT + SZ_WINT), 2048, kt * 256, RmWin(), scr); }
            } else if (G == 256 && c >= 208) {
                LAS float* scr = (LAS float*)lds;
                for (int j = 1536 + (c - 208); j < 2048; j += 48) { const int q = j - 1024, kt = q >> 5, ntile = q & 31;
                    tr_tile(p.w_mlp_out + (size_t)8192 * 2048, 2048, kt * 256, ntile * 64, (bf16_t*)(ws + O_WMO + SZ_WMO), 8192, kt * 256, RmId(), scr); }
            } }
        else if (sp == 1) { phase_mix(p, lds, (LAS int*)(lds + LDS_BYTES), l, 0); }
        else if (sp == 2) { SchedGrid S; S.A = (const char*)(ws + O_CAT); S.B = (const char*)(ws + O_WOUTF + l * SZ_WOUTF); S.lda = 2048; S.ldb = 2048; S.nM = 32; S.nN = 8; S.nt = 32; S.nsplit = cx ? 8 : 0; S.G = G; S.c = c;
            EpiY E; E.Y = (bf16_t*)(ws + O_Y); E.YP = (bf16_t*)(ws + O_YP); E.split_stride = (size_t)NCTX * D; pg8::gemm_phase(lds, 2048, 2048, S, E); }
        else if (sp == 3) { RowArgs a{}; a.mode = 1; a.hasH = true; a.nrows = cx ? NROW : NLAT; a.xlat = xl; a.xctx = xc; a.olat = p.out; a.octx = (float*)(ws + O_CX);
            a.Y = (const bf16_t*)(ws + O_Y); a.YP = (const bf16_t*)(ws + O_YP); a.bias = (const float*)(ws + O_BO) + l * 2048; a.gpost = p.g_post_mix + l * D; a.gn = p.g_pre_mlp + l * D;
            a.mod = MOD + (size_t)l * 5 * 12288; a.modn = a.mod; a.gate_off = 4096; a.sh_off = 6144; a.sc_off = 8192; a.H = (bf16_t*)(ws + O_H); a.x16 = (const bf16_t*)(ws + O_X16); a.o16 = (bf16_t*)(ws + O_X16); a.in16 = !cx; a.out16 = true; phase_rows(a); }
        else if (sp == 4) { SchedGrid S; S.A = (const char*)(ws + O_H); S.B = (const char*)(ws + O_WMI + l * SZ_WMI); S.lda = 2048; S.ldb = 2048; S.nM = cx ? 36 : 32; S.nN = 32; S.nt = 32; S.nsplit = 0; S.G = G; S.c = c;
            EpiBf16<1> E; E.O = (bf16_t*)(ws + O_T); E.ldc = DFF; pg8::gemm_phase(lds, 2048, 2048, S, E);
            if (cx && G == 256 ? c >= 128 : false) {
                LAS float* scr = (LAS float*)lds;
                for (int j = c - 128; j < 1536; j += 128) {
                    if (j < 1024) { const int kt = j >> 7, ntile = j & 127; tr_tile(p.w_mlp_in + (size_t)2048 * 8192, 8192, kt * 256, ntile * 64, (bf16_t*)(ws + O_WMI + SZ_WMI), 2048, kt * 256, RmId(), scr); }
                    else { const int q = j - 1024, kt = q >> 5, ntile = q & 31; tr_tile(p.w_mlp_out + (size_t)8192 * 2048, 2048, kt * 256, ntile * 64, (bf16_t*)(ws + O_WMO + SZ_WMO), 8192, kt * 256, RmId(), scr); }
                }
            } else if (cx && G != 256) {
                LAS float* scr = (LAS float*)lds;
                for (int j = c; j < 2048; j += G) {
                    if (j < 1024) { const int kt = j >> 7, ntile = j & 127; tr_tile(p.w_mlp_in + (size_t)2048 * 8192, 8192, kt * 256, ntile * 64, (bf16_t*)(ws + O_WMI + SZ_WMI), 2048, kt * 256, RmId(), scr); }
                    else { const int q = j - 1024, kt = q >> 5, ntile = q & 31; tr_tile(p.w_mlp_out + (size_t)8192 * 2048, 2048, kt * 256, ntile * 64, (bf16_t*)(ws + O_WMO + SZ_WMO), 8192, kt * 256, RmId(), scr); }
                }
            } }
        else if (sp == 5) { SchedGrid S; S.A = (const char*)(ws + O_T); S.B = (const char*)(ws + O_WMO + l * SZ_WMO); S.lda = 8192; S.ldb = 8192; S.nM = 32; S.nN = 8; S.nt = 128; S.nsplit = cx ? 8 : 0; S.G = G; S.c = c;
            EpiY E; E.Y = (bf16_t*)(ws + O_Y); E.YP = (bf16_t*)(ws + O_YP); E.split_stride = (size_t)NCTX * D; pg8::gemm_phase(lds, 8192, 8192, S, E); }
        else { RowArgs a{}; a.mode = 1; a.hasH = cx; a.nrows = cx ? NROW : NLAT; a.xlat = p.out; a.xctx = (const float*)(ws + O_CX); a.olat = p.out; a.octx = (float*)(ws + O_CX);
            a.Y = (const bf16_t*)(ws + O_Y); a.YP = (const bf16_t*)(ws + O_YP); a.bias = nullptr; a.gpost = p.g_post_mlp + l * D; a.gn = p.g_pre_mix + (l + 1 < 2 ? l + 1 : l) * D;
            a.mod = MOD + (size_t)l * 5 * 12288; a.modn = MOD + (size_t)(l + 1 < 2 ? l + 1 : l) * 5 * 12288; a.gate_off = 10240; a.sh_off = 0; a.sc_off = 2048; a.H = (bf16_t*)(ws + O_H); a.x16 = (const bf16_t*)(ws + O_X16); a.o16 = (bf16_t*)(ws + O_X16); a.in16 = true; a.out16 = cx; phase_rows(a); }
        }
    }
}

extern "C" void kernel_launch(void* const* d_in, const int* in_sizes, int n_in, void* d_out, int out_size, void* d_ws, size_t ws_size, hipStream_t stream) {
    static int grid = 0;
    if (grid == 0) {
        if (n_in != 26 || ws_size < WS_END) { fprintf(stderr, "kernel_launch: unexpected n_in %d or workspace %zu < %zu\n", n_in, ws_size, (size_t)WS_END); }
        int dev = 0, cus = 0, per_cu = 0;
        (void)hipGetDevice(&dev); (void)hipDeviceGetAttribute(&cus, hipDeviceAttributeMultiprocessorCount, dev);
        (void)hipFuncSetAttribute((const void*)mega, hipFuncAttributeMaxDynamicSharedMemorySize, LDS_TOTAL);
        (void)hipOccupancyMaxActiveBlocksPerMultiprocessor(&per_cu, (const void*)mega, NTHR, LDS_TOTAL);
        if (per_cu < 1) { fprintf(stderr, "kernel_launch: occupancy query says %d blocks/CU\n", per_cu); per_cu = 1; }
        (void)hipGetLastError();
        grid = cus * 1;
    }
    (void)hipMemsetAsync((unsigned char*)d_ws + O_BAR, 0, 16384, stream);
    Params p{};
    const float** f = (const float**)&p;
    for (int i = 0; i < 26; ++i) f[i] = (const float*)d_in[i];
    p.out = (float*)d_out; p.ws = (unsigned char*)d_ws;
#if MK_MULTI
    for (int ph = 0; ph < NPH; ++ph) { p.ph_lo = ph; p.ph_hi = ph + 1; hipLaunchKernelGGL(mega, dim3(grid), dim3(NTHR), LDS_TOTAL, stream, p); }
#else
    p.ph_lo = 0; p.ph_hi = NPH;
    void* args[] = {&p};
    hipError_t e = hipLaunchCooperativeKernel((const void*)mega, dim3(grid), dim3(NTHR), args, LDS_TOTAL, stream);
    if (e != hipSuccess) fprintf(stderr, "cooperative launch failed: %s (grid %d)\n", hipGetErrorString(e), grid);
#endif
}
```
